# Optimizing an MI355X kernel written in HIP

```python
import jax
import jax.numpy as jnp
from jax import lax
import numpy as np

D_MODEL = 2048
BATCH = 8
SEQ = 4096
DEPTH = 2

GRID_W = 64
CTX_LEN = 256
HEAD_DIM = 128
N_BRANCH = 4
BRANCH_W = D_MODEL // 4
POOL_WINDOWS = (2, 4, 8, 16)
POOL_GROUP = BRANCH_W // len(POOL_WINDOWS)
RWKV_HEAD = 64
RWKV_HEADS = BRANCH_W // RWKV_HEAD
DECAY_LORA = 96
ICLR_LORA = 96
GATE_LORA = 256
RWKV_SHIFT_W = 3 * BRANCH_W + 2 * DECAY_LORA + 2 * ICLR_LORA + GATE_LORA
WIN = 128
BLOCK = 128
C_QH = 4
C_KVH = 2
D_QH = 4
D_KVH = 2
ATT_W_C = (C_QH + 2 * C_KVH) * HEAD_DIM
ATT_W_D = (D_QH + 2 * D_KVH) * HEAD_DIM
IN_W = BRANCH_W + RWKV_SHIFT_W + ATT_W_C + ATT_W_D + N_BRANCH * D_MODEL
D_FF = 256 * ((8 * D_MODEL // 3 + 255) // 256)
N_MOD = 9
ROPE_THETA = 10000.0
DEEPNORM_ALPHA = (2 * DEPTH) ** 0.25
DEEPNORM_BETA = (8 * DEPTH) ** -0.25
LN_EPS = 1e-6
RMS_EPS = 1e-6
GN_EPS = 64e-5
NEG_INF = -1e30
F32 = jnp.float32

kernel_name = 'hybrid_pool_rwkv7_swa_axialgqa_dit_trunk'


def _layer_norm(z, g, b):
    zf = z.astype(F32)
    mu = jnp.mean(zf, -1, keepdims=True)
    var = jnp.mean(jnp.square(zf - mu), -1, keepdims=True)
    return ((zf - mu) * lax.rsqrt(var + LN_EPS) * g + b).astype(z.dtype)


def _post_norm(x, y, gate, g, b):
    return _layer_norm(DEEPNORM_ALPHA * x + gate * y, g, b)


def _modulate(x, shift, scale):
    return x * (1.0 + scale) + shift


def _swiglu(h, wi, wo):
    gate, up = jnp.split(h @ wi, 2, axis=-1)
    return (jax.nn.silu(gate) * up) @ wo


def _rms_norm(u, g):
    uf = u.astype(F32)
    return (uf * lax.rsqrt(jnp.mean(uf * uf, -1, keepdims=True) + RMS_EPS) * g).astype(u.dtype)


def _axial_rope(rows):
    n = rows * GRID_W
    row = jnp.repeat(jnp.arange(rows), GRID_W).astype(F32)
    col = (jnp.arange(n) % GRID_W).astype(F32)
    n_freq = HEAD_DIM // 4
    inv = ROPE_THETA ** (-jnp.arange(n_freq, dtype=F32) / n_freq)
    ang = jnp.stack([row[:, None] * inv, col[:, None] * inv], axis=1)
    return jnp.cos(ang), jnp.sin(ang)


def _rope(x, cos, sin):
    B, S, H, _ = x.shape
    xr = x.astype(F32).reshape(B, S, H, 2, 2, HEAD_DIM // 4)
    x1, x2 = xr[..., 0, :], xr[..., 1, :]
    c = cos[None, :, None]
    s = sin[None, :, None]
    out = jnp.stack([x1 * c - x2 * s, x2 * c + x1 * s], axis=-2)
    return out.reshape(x.shape).astype(x.dtype)


def _split_in(z, b_gate):
    o1 = BRANCH_W
    o2 = o1 + RWKV_SHIFT_W
    o3 = o2 + ATT_W_C
    o4 = o3 + ATT_W_D
    gates = jax.nn.sigmoid((z[..., o4:] + b_gate).astype(F32)).astype(z.dtype)
    return z[..., :o1], z[..., o1:o2], z[..., o2:o3], z[..., o3:o4], gates


def _qkv(z, hq, hk):
    B, T, _ = z.shape
    q = z[..., :hq * HEAD_DIM].reshape(B, T, hq, HEAD_DIM)
    k = z[..., hq * HEAD_DIM:(hq + hk) * HEAD_DIM].reshape(B, T, hk, HEAD_DIM)
    v = z[..., (hq + hk) * HEAD_DIM:].reshape(B, T, hk, HEAD_DIM)
    return q, k, v


def _pool_branch(u, pool_w, pool_scale):
    B, T, _ = u.shape
    ug = u.astype(F32).reshape(B, T, len(POOL_WINDOWS), POOL_GROUP)
    cs = jnp.concatenate([jnp.zeros((B, 1) + ug.shape[2:], F32), jnp.cumsum(ug, axis=1)], axis=1)
    t = jnp.arange(T)
    means = []
    for gi, win in enumerate(POOL_WINDOWS):
        lo = jnp.clip(t - win // 2, 0, T)
        hi = jnp.clip(t + win // 2, 0, T)
        means.append((cs[:, hi, gi] - cs[:, lo, gi]) / (hi - lo).astype(F32)[None, :, None])
    pooled = jnp.stack(means, axis=2) - ug
    y = jnp.einsum('btgc,gcd->btgd', pooled, pool_w.astype(F32)).reshape(B, T, BRANCH_W)
    return (y * pool_scale).astype(u.dtype)


def _centred_shift(u, mu):
    zero = jnp.zeros_like(u[:, :1])
    prev = jnp.concatenate([zero, u[:, :-1]], axis=1)
    nxt = jnp.concatenate([u[:, 1:], zero], axis=1)
    return u + (0.5 * (prev + nxt) - u) * mu


def _heads64(u):
    return u.reshape(u.shape[:-1] + (RWKV_HEADS, RWKV_HEAD))


def _rwkv_prep(zr, p):
    B, T, _ = zr.shape
    zr = _centred_shift(zr.astype(F32), p['rwkv_mu'])
    o1, o2, o3 = BRANCH_W, 2 * BRANCH_W, 3 * BRANCH_W
    o4 = o3 + 2 * DECAY_LORA
    o5 = o4 + 2 * ICLR_LORA
    r, k, v = zr[..., :o1], zr[..., o1:o2], zr[..., o2:o3]
    wd = zr[..., o3:o4].reshape(B, T, 2, DECAY_LORA)
    ad = zr[..., o4:o5].reshape(B, T, 2, ICLR_LORA)
    gd = zr[..., o5:]
    z_w = p['rwkv_w0'] + jnp.einsum('btdr,drc->btdc', jnp.tanh(wd), p['rwkv_w2'])
    decay = jnp.exp(-jnp.exp(-jax.nn.softplus(-z_w) - 0.5))
    a = jax.nn.sigmoid(p['rwkv_a0'] + jnp.einsum('btdr,drc->btdc', ad, p['rwkv_a2']))
    g = jax.nn.sigmoid(gd) @ p['rwkv_g2']
    kk = _heads64(k * p['rwkv_kk'])
    kk = kk * lax.rsqrt(jnp.sum(kk * kk, -1, keepdims=True) + 1e-12)
    a_h = _heads64(a)
    k_rep = _heads64(k)[:, :, None] * (1.0 + (a_h - 1.0) * _heads64(p['rwkv_ka']))
    b = kk[:, :, None] * a_h
    return _heads64(r), _heads64(decay), k_rep, _heads64(v), kk, b, g


def _dirs_shared(u):
    return jnp.moveaxis(jnp.stack([u, u[:, ::-1]], 0), 2, 0)


def _dirs_split(u):
    return jnp.moveaxis(jnp.stack([u[:, :, 0], u[:, ::-1, 1]], 0), 2, 0)


def _rwkv_scan(S0, r, w, k, v, kk, b):
    def step(S, inp):
        r_t, w_t, k_t, v_t, kk_t, b_t = inp
        sk = jnp.einsum('dbhij,dbhj->dbhi', S, kk_t)
        S = S * w_t[..., None, :] - sk[..., :, None] * b_t[..., None, :] + v_t[..., :, None] * k_t[..., None, :]
        return S, jnp.einsum('dbhij,dbhj->dbhi', S, r_t)
    S, o = lax.scan(step, S0, (r, w, k, v, kk, b))
    return S, jnp.moveaxis(o, 0, 2)


def _rwkv_scan_inputs(prep):
    r, w, k_rep, v, kk, b, _ = prep
    return (_dirs_shared(r), _dirs_split(w), _dirs_split(k_rep), _dirs_shared(v), _dirs_shared(kk), _dirs_split(b))


def _rwkv_out(o, prep, p):
    r, _, k_rep, v, _, _, g = prep
    B, T = r.shape[:2]
    s = o[0] + o[1][:, ::-1]
    mu = jnp.mean(s, -1, keepdims=True)
    var = jnp.mean(jnp.square(s - mu), -1, keepdims=True)
    y = ((s - mu) * lax.rsqrt(var + GN_EPS)).reshape(B, T, BRANCH_W) * p['rwkv_gn_g'] + p['rwkv_gn_b']
    rk = _heads64(p['rwkv_rk'])
    bonus = jnp.sum(r[:, :, None] * k_rep * rk, axis=(2, 4))[..., None] * v
    return (y + bonus.reshape(B, T, BRANCH_W)) * g


def _rwkv_branch(zr_x, zr_c, p, ctx_out):
    B = zr_x.shape[0]
    prep_c = _rwkv_prep(zr_c, p)
    prep_x = _rwkv_prep(zr_x, p)
    S0 = jnp.zeros((2, B, RWKV_HEADS, RWKV_HEAD, RWKV_HEAD), F32)
    S_ctx, o_c = _rwkv_scan(S0, *_rwkv_scan_inputs(prep_c))
    _, o_x = _rwkv_scan(S_ctx, *_rwkv_scan_inputs(prep_x))
    y_x = _rwkv_out(o_x, prep_x, p).astype(zr_x.dtype)
    y_c = _rwkv_out(o_c, prep_c, p).astype(zr_c.dtype) if ctx_out else None
    return y_x, y_c


def _window_sink_attn(q, k, v, kc, vc, sink):
    B, S, Hq, Dh = q.shape
    Hk = k.shape[2]
    G = Hq // Hk
    nb = S // BLOCK
    L = kc.shape[1]
    scale = Dh ** -0.5
    qb = q.reshape(B, nb, BLOCK, Hk, G, Dh)
    pad = jnp.zeros((B, BLOCK, Hk, Dh), k.dtype)

    def band(t):
        tb = jnp.concatenate([pad, t, pad], axis=1).reshape(B, nb + 2, BLOCK, Hk, Dh)
        return jnp.concatenate([tb[:, :-2], tb[:, 1:-1], tb[:, 2:]], axis=2)

    kw, vw = band(k), band(v)
    qpos = (jnp.arange(nb) * BLOCK)[:, None, None] + jnp.arange(BLOCK)[None, :, None]
    kpos = (jnp.arange(nb) * BLOCK - BLOCK)[:, None, None] + jnp.arange(3 * BLOCK)[None, None, :]
    allowed = (jnp.abs(qpos - kpos) <= WIN) & (kpos >= 0) & (kpos < S)
    s_loc = jnp.einsum('bnqhgd,bnkhd->bnhgqk', qb, kw).astype(F32) * scale
    s_loc = jnp.where(allowed[None, :, None, None], s_loc, NEG_INF)
    s_ctx = jnp.einsum('bnqhgd,bchd->bnhgqc', qb, kc).astype(F32) * scale
    s_sink = jnp.broadcast_to(sink.astype(F32).reshape(1, 1, Hk, G, 1, 1), s_ctx.shape[:-1] + (1,))
    p = jax.nn.softmax(jnp.concatenate([s_ctx, s_loc, s_sink], axis=-1), axis=-1).astype(v.dtype)
    o = (jnp.einsum('bnhgqc,bchd->bnqhgd', p[..., :L], vc)
         + jnp.einsum('bnhgqk,bnkhd->bnqhgd', p[..., L:L + 3 * BLOCK], vw))
    return o.reshape(B, S, Hq * Dh)


def _gqa_full(q, k, v, sink):
    B, T, Hq, Dh = q.shape
    Hk = k.shape[2]
    G = Hq // Hk
    s = jnp.einsum('bqhgd,bkhd->bhgqk', q.reshape(B, T, Hk, G, Dh), k).astype(F32) * Dh ** -0.5
    if sink is not None:
        s = jnp.concatenate([s, jnp.broadcast_to(sink.astype(F32).reshape(Hk, G, 1, 1), s.shape[:-1] + (1,))], axis=-1)
    p = jax.nn.softmax(s, axis=-1)[..., :k.shape[1]].astype(v.dtype)
    return jnp.einsum('bhgqk,bkhd->bqhgd', p, v).reshape(B, T, Hq * Dh)


def _dense_block_attn(q, k, v):
    B, S, Hq, Dh = q.shape
    Hk = k.shape[2]
    G = Hq // Hk
    nb = S // BLOCK
    scale = Dh ** -0.5
    qb = jnp.moveaxis(q.reshape(B, nb, BLOCK, Hk, G, Dh), 1, 0)

    def block(qi):
        s = jnp.einsum('bqhgd,bkhd->bhgqk', qi, k).astype(F32) * scale
        p = jax.nn.softmax(s, axis=-1).astype(v.dtype)
        return jnp.einsum('bhgqk,bkhd->bqhgd', p, v)

    o = lax.map(block, qb)
    return jnp.moveaxis(o, 0, 1).reshape(B, S, Hq * Dh)


def _merge(branches, gates, w_up, w_out):
    B, T, _ = gates.shape
    g = gates.reshape(B, T, N_BRANCH, D_MODEL)
    acc = g[:, :, 0] * (branches[0] @ w_up[0])
    for i in range(1, N_BRANCH):
        acc = acc + g[:, :, i] * (branches[i] @ w_up[i])
    return acc @ w_out


def _mixer(hx, hc, p, cos, sin, ctx_out):
    zx = hx @ p['w_in']
    zc = hc @ p['w_in']
    pool_x, rwkv_x, win_x, dense_x, gate_x = _split_in(zx, p['b_gate'])
    pool_c, rwkv_c, win_c, dense_c, gate_c = _split_in(zc, p['b_gate'])
    ya_x = _pool_branch(pool_x, p['pool_w'], p['pool_scale'])
    yb_x, yb_c = _rwkv_branch(rwkv_x, rwkv_c, p, ctx_out)
    qx, kx, vx = _qkv(win_x, C_QH, C_KVH)
    qc, kc, vc = _qkv(win_c, C_QH, C_KVH)
    yc_x = _window_sink_attn(_rope(qx, cos, sin), _rope(kx, cos, sin), vx, kc, vc, p['c_sink'])
    dqx, dkx, dvx = _qkv(dense_x, D_QH, D_KVH)
    dqc, dkc, dvc = _qkv(dense_c, D_QH, D_KVH)
    dqx = _rope(_rms_norm(dqx, p['d_qnorm']), cos, sin)
    dkx = _rope(_rms_norm(dkx, p['d_knorm']), cos, sin)
    dqc = _rms_norm(dqc, p['d_qnorm'])
    dkc = _rms_norm(dkc, p['d_knorm'])
    yd_x = _dense_block_attn(dqx, jnp.concatenate([dkc, dkx], axis=1), jnp.concatenate([dvc, dvx], axis=1))
    out_x = _merge((ya_x, yb_x, yc_x, yd_x), gate_x, p['w_up'], p['w_out'])
    if not ctx_out:
        return out_x, None
    ya_c = _pool_branch(pool_c, p['pool_w'], p['pool_scale'])
    yc_c = _gqa_full(qc, kc, vc, p['c_sink'])
    yd_c = _gqa_full(dqc, dkc, dvc, None)
    out_c = _merge((ya_c, yb_c, yc_c, yd_c), gate_c, p['w_up'], p['w_out'])
    return out_x, out_c


def setup_inputs(seed: int = 0) -> dict:
    key = jax.random.key(seed)
    ks = iter(jax.random.split(key, 40))

    def nrm(shape, scale):
        return scale * jax.random.normal(next(ks), shape, F32)

    def unif(shape, lo, hi):
        return jax.random.uniform(next(ks), shape, F32, lo, hi)

    L, D, C = DEPTH, D_MODEL, BRANCH_W
    return {
        'x': nrm((BATCH, SEQ, D), 1.0),
        'c': nrm((BATCH, D), 1.0),
        'ctx': nrm((BATCH, CTX_LEN, D), 1.0),
        'c_ctx': nrm((D,), 1.0),
        'w_mod': nrm((L, D, N_MOD * D), 0.5 * D ** -0.5),
        'b_mod': nrm((L, N_MOD * D), 0.02),
        'ln_g': 1.0 + nrm((L, 3, D), 0.02),
        'ln_b': nrm((L, 3, D), 0.02),
        'ffn1_wi': nrm((L, D, 2 * D_FF), D ** -0.5),
        'ffn1_wo': nrm((L, D_FF, D), DEEPNORM_BETA * D_FF ** -0.5),
        'ffn2_wi': nrm((L, D, 2 * D_FF), D ** -0.5),
        'ffn2_wo': nrm((L, D_FF, D), DEEPNORM_BETA * D_FF ** -0.5),
        'w_in': nrm((L, D, IN_W), D ** -0.5),
        'b_gate': nrm((L, N_BRANCH * D), 0.02),
        'pool_w': nrm((L, len(POOL_WINDOWS), POOL_GROUP, POOL_GROUP), POOL_GROUP ** -0.5),
        'pool_scale': 1.0 + nrm((L, C), 0.02),
        'rwkv_mu': unif((L, RWKV_SHIFT_W), 0.0, 1.0),
        'rwkv_w0': unif((L, 2, C), -6.0, 1.0),
        'rwkv_w2': nrm((L, 2, DECAY_LORA, C), 0.1 * DECAY_LORA ** -0.5),
        'rwkv_a0': nrm((L, 2, C), 0.5),
        'rwkv_a2': nrm((L, 2, ICLR_LORA, C), 0.5 * ICLR_LORA ** -0.5),
        'rwkv_g2': nrm((L, GATE_LORA, C), GATE_LORA ** -0.5),
        'rwkv_kk': 0.85 + nrm((L, C), 0.05),
        'rwkv_ka': 1.0 + nrm((L, C), 0.05),
        'rwkv_rk': nrm((L, C), 0.1),
        'rwkv_gn_g': 1.0 + nrm((L, C), 0.02),
        'rwkv_gn_b': nrm((L, C), 0.02),
        'c_sink': nrm((L, C_QH), 1.0),
        'd_qnorm': 1.0 + nrm((L, HEAD_DIM), 0.02),
        'd_knorm': 1.0 + nrm((L, HEAD_DIM), 0.02),
        'w_up': nrm((L, N_BRANCH, C, D), C ** -0.5),
        'w_out': nrm((L, D, D), DEEPNORM_BETA * D ** -0.5),
    }


def reference(x, c, ctx, c_ctx, w_mod, b_mod, ln_g, ln_b, ffn1_wi, ffn1_wo, ffn2_wi, ffn2_wo,
              w_in, b_gate, pool_w, pool_scale, rwkv_mu, rwkv_w0, rwkv_w2, rwkv_a0, rwkv_a2, rwkv_g2,
              rwkv_kk, rwkv_ka, rwkv_rk, rwkv_gn_g, rwkv_gn_b, c_sink, d_qnorm, d_knorm, w_up, w_out):
    B, n, _ = x.shape
    rows = n // GRID_W
    cos, sin = _axial_rope(rows)
    sc = jax.nn.silu(c)
    scc = jax.nn.silu(c_ctx)
    xc = ctx
    for l in range(DEPTH):
        last = l == DEPTH - 1
        p = {'w_in': w_in[l], 'b_gate': b_gate[l], 'pool_w': pool_w[l], 'pool_scale': pool_scale[l],
             'rwkv_mu': rwkv_mu[l], 'rwkv_w0': rwkv_w0[l], 'rwkv_w2': rwkv_w2[l], 'rwkv_a0': rwkv_a0[l],
             'rwkv_a2': rwkv_a2[l], 'rwkv_g2': rwkv_g2[l], 'rwkv_kk': rwkv_kk[l], 'rwkv_ka': rwkv_ka[l],
             'rwkv_rk': rwkv_rk[l], 'rwkv_gn_g': rwkv_gn_g[l], 'rwkv_gn_b': rwkv_gn_b[l],
             'c_sink': c_sink[l], 'd_qnorm': d_qnorm[l], 'd_knorm': d_knorm[l],
             'w_up': w_up[l], 'w_out': w_out[l]}
        mod = (sc @ w_mod[l] + b_mod[l]).reshape(B, N_MOD, 1, D_MODEL)
        modc = (scc @ w_mod[l] + b_mod[l]).reshape(N_MOD, D_MODEL)
        x = _post_norm(x, 0.5 * _swiglu(_modulate(x, mod[:, 0], mod[:, 1]), ffn1_wi[l], ffn1_wo[l]),
                       mod[:, 2], ln_g[l, 0], ln_b[l, 0])
        xc = _post_norm(xc, 0.5 * _swiglu(_modulate(xc, modc[0], modc[1]), ffn1_wi[l], ffn1_wo[l]),
                        modc[2], ln_g[l, 0], ln_b[l, 0])
        yx, yc = _mixer(_modulate(x, mod[:, 3], mod[:, 4]), _modulate(xc, modc[3], modc[4]),
                        p, cos, sin, not last)
        x = _post_norm(x, yx, mod[:, 5], ln_g[l, 1], ln_b[l, 1])
        x = _post_norm(x, 0.5 * _swiglu(_modulate(x, mod[:, 6], mod[:, 7]), ffn2_wi[l], ffn2_wo[l]),
                       mod[:, 8], ln_g[l, 2], ln_b[l, 2])
        if not last:
            xc = _post_norm(xc, yc, modc[5], ln_g[l, 1], ln_b[l, 1])
            xc = _post_norm(xc, 0.5 * _swiglu(_modulate(xc, modc[6], modc[7]), ffn2_wi[l], ffn2_wo[l]),
                            modc[8], ln_g[l, 2], ln_b[l, 2])
    return x
```

```cpp
#include <hip/hip_runtime.h>
#include <cstdio>
#include <cstdint>

namespace pg8 {
#define PG8_LAS __attribute__((address_space(3)))
typedef unsigned short bf16_t;
typedef short bf16x8 __attribute__((ext_vector_type(8)));
typedef float f32x4 __attribute__((ext_vector_type(4)));
typedef unsigned u32x4 __attribute__((ext_vector_type(4)));
constexpr int BM = 256, BK = 64, HALF = 128, HTB = HALF * BK * 2  , STAGE_BYTES = 8 * HTB, NXCD = 8, WGM = 4;

__host__ __device__ __forceinline__ int lds_byte(int r, int c) { const int st = (r >> 4) * 2 + (c >> 5), rr = r & 15, cc = c & 31, ob = rr * 64 + cc * 2; return st * 1024 + (ob ^ (((ob >> 9) & 1) << 5)); }
__host__ __device__ __forceinline__ void stage_rc(int b, int& R, int& C) { const int st = b / 1024, sb = b % 1024, swz = sb ^ (((sb >> 9) & 1) << 5); R = (st >> 1) * 16 + swz / 64; C = (st & 1) * 32 + (swz % 64) / 2; }
__host__ __device__ __forceinline__ int perm32(int rho) { const int n = rho >> 4, i = rho & 15; return 8 * (i >> 2) + 4 * n + (i & 3); }

struct Unit { int pm, pn, half; };
struct Gemm { const bf16_t* A; const bf16_t* Bt; int M, N, K, lda; };

struct PanelOrder {
    int nM, nN, nwg, G, c, mode;
    __device__ void init(int nM_, int nN_, int G_, int c_, int mode_) { nM = nM_; nN = nN_; nwg = nM * nN; G = G_; c = c_; mode = mode_; }
    __device__ bool next(int i, Unit& u) const {
        const int full = (nwg / G) * G, T = nwg - full;
        long L = (long)i * G + c; int half = 0;
        if (L >= full) { if (L >= (long)full + G) return false; const int ti = (int)(L - full);
            if (T > 0 && 2 * T <= G && (G & 15) == 0) { const int p = (ti >> 4) * 8 + (ti & 7); if (p >= T) return false; L = full + p; half = 1 + ((ti >> 3) & 1); }
            else if (ti >= T) return false; }
        int wgid = (int)L; { const int q = nwg / NXCD, r = nwg % NXCD, xcd = wgid % NXCD, off = wgid / NXCD; wgid = (xcd < r ? xcd * (q + 1) : r * (q + 1) + (xcd - r) * q) + off; }
        const int nig = WGM * nN, gid = wgid / nig, fm = gid * WGM, gsz = (nM - fm) < WGM ? (nM - fm) : WGM;
        int pm = fm + ((wgid % nig) % gsz); u.pn = (wgid % nig) / gsz;
        if (mode == 1) pm = (pm >> 4) * 17 + 1 + (pm & 15);
        u.pm = pm; u.half = half; return true;
    }
    __device__ __forceinline__ void a_ready(const Unit&) const {}
    __device__ __forceinline__ void done(const Unit&) const {}
};

typedef float f32x2c_ __attribute__((ext_vector_type(2))); typedef __bf16 bf16x2c_ __attribute__((ext_vector_type(2)));
__device__ __forceinline__ unsigned cvt_pk_bf16(float lo, float hi) { const f32x2c_ v = {lo, hi}; const bf16x2c_ b = __builtin_convertvector(v, bf16x2c_); return __builtin_bit_cast(unsigned, b); }
__device__ __forceinline__ float bf_lo(unsigned w) { return __uint_as_float(w << 16); }
__device__ __forceinline__ float bf_hi(unsigned w) { return __uint_as_float(w & 0xffff0000u); }
__device__ __forceinline__ float fast_sigmoid(float x) { return __builtin_amdgcn_rcpf(1.0f + __builtin_amdgcn_exp2f(-1.4426950408889634f * x)); }


struct EpiStore {
    static constexpr bool PERM = true, AFTER_DRAIN = false;
    bf16_t* O; int ldc;
    __device__ __forceinline__ void operator()(const f32x4 (&acc)[2][2][4][2], const Unit& u, int wr, int wc, int fr, int fq) const {
        const int row0 = u.pm * BM + wr * 64 + fr, col0 = u.pn * BM + wc * 32 + 8 * fq;
#pragma unroll
        for (int ai = 0; ai < 2; ++ai) { if (u.half && u.half != ai + 1) continue;
#pragma unroll
            for (int m = 0; m < 4; ++m) { bf16_t* rowp = O + (size_t)(row0 + ai * HALF + m * 16) * ldc + col0;
#pragma unroll
                for (int bj = 0; bj < 2; ++bj) { const f32x4 v0 = acc[ai][bj][m][0], v1 = acc[ai][bj][m][1];
                    u32x4 w; w.x = cvt_pk_bf16(v0[0], v0[1]); w.y = cvt_pk_bf16(v0[2], v0[3]); w.z = cvt_pk_bf16(v1[0], v1[1]); w.w = cvt_pk_bf16(v1[2], v1[3]);
                    *(u32x4*)(rowp + bj * HALF) = w; } } }
    }
};
struct EpiStoreP {
    static constexpr bool PERM = true, AFTER_DRAIN = false;
    bf16_t* O; int nN;
    __device__ __forceinline__ void operator()(const f32x4 (&acc)[2][2][4][2], const Unit& u, int wr, int wc, int fr, int fq) const {
        const int t = ((wr * 4 + wc) * 64) + fq * 16 + fr;
        bf16_t* base = O + ((size_t)(u.pm * nN + u.pn) * 16) * 4096 + t * 8;
#pragma unroll
        for (int ai = 0; ai < 2; ++ai) { if (u.half && u.half != ai + 1) continue;
#pragma unroll
            for (int m = 0; m < 4; ++m)
#pragma unroll
                for (int bj = 0; bj < 2; ++bj) { const f32x4 v0 = acc[ai][bj][m][0], v1 = acc[ai][bj][m][1];
                    u32x4 w; w.x = cvt_pk_bf16(v0[0], v0[1]); w.y = cvt_pk_bf16(v0[2], v0[3]); w.z = cvt_pk_bf16(v1[0], v1[1]); w.w = cvt_pk_bf16(v1[2], v1[3]);
                    *(u32x4*)(base + ((ai * 4 + m) * 2 + bj) * 4096) = w; } }
    }
};
struct EpiSwiglu {
    static constexpr bool PERM = true, AFTER_DRAIN = false;
    bf16_t* O; int ldc; int dry;
    __device__ __forceinline__ void operator()(const f32x4 (&acc)[2][2][4][2], const Unit& u, int wr, int wc, int fr, int fq) const {
        const int row0 = u.pm * BM + wr * 64 + fr, col0 = u.pn * HALF + wc * 32 + 8 * fq;
#pragma unroll
        for (int ai = 0; ai < 2; ++ai) { if (u.half && u.half != ai + 1) continue;
#pragma unroll
            for (int m = 0; m < 4; ++m) { bf16_t* rowp = O + (size_t)(row0 + ai * HALF + m * 16) * ldc + col0;
                float o[8];
#pragma unroll
                for (int n = 0; n < 2; ++n)
#pragma unroll
                    for (int j = 0; j < 4; ++j) { const float gt = acc[ai][0][m][n][j], up = acc[ai][1][m][n][j]; o[n * 4 + j] = gt * fast_sigmoid(gt) * up; }
                u32x4 w; w.x = cvt_pk_bf16(o[0], o[1]); w.y = cvt_pk_bf16(o[2], o[3]); w.z = cvt_pk_bf16(o[4], o[5]); w.w = cvt_pk_bf16(o[6], o[7]);
                if (!dry) *(u32x4*)rowp = w; else asm volatile("" :: "v"(w)); } }
    }
};
struct EpiResid {
    static constexpr bool PERM = true, AFTER_DRAIN = false;
    _Float16* X;
    const float* gate;
    float alpha, scale; int dry;
    const float* stats; const float* lg; const float* lb;
    __device__ __forceinline__ void operator()(const f32x4 (&acc)[2][2][4][2], const Unit& u, int wr, int wc, int fr, int fq) const {
        typedef float f32x2 __attribute__((ext_vector_type(2))); typedef _Float16 f16x4 __attribute__((ext_vector_type(4))); typedef _Float16 f16x8 __attribute__((ext_vector_type(8)));
        const int b = u.pm / 17, p = u.pm - b * 17, bi = (p == 0) ? 8 : b;
        _Float16* dst = X + (size_t)u.pm * BM * 2048;
        const int rl0 = wr * 64 + fr, col0 = u.pn * BM + wc * 32 + 8 * fq;
        const float* gp = gate + (size_t)bi * 9 * 2048 + col0;
        const float* stp = stats + 2 * (size_t)(u.pm * BM + rl0);
#pragma unroll
        for (int bj = 0; bj < 2; ++bj) { const int co = bj * HALF;
            const f32x4 gv0 = *(const f32x4*)(gp + co) * scale, lgv0 = *(const f32x4*)(lg + col0 + co), lbv0 = *(const f32x4*)(lb + col0 + co);
            const f32x4 gv1 = *(const f32x4*)(gp + co + 4) * scale, lgv1 = *(const f32x4*)(lg + col0 + co + 4), lbv1 = *(const f32x4*)(lb + col0 + co + 4);
#pragma unroll
            for (int ai = 0; ai < 2; ++ai) { if (u.half && u.half != ai + 1) continue;
#pragma unroll
                for (int m = 0; m < 4; ++m) { const unsigned off = (unsigned)(rl0 + ai * HALF + m * 16) * 2048u + (unsigned)(col0 + co);
                    const f32x2 stv = *(const f32x2*)(stp + 2 * (ai * HALF + m * 16)); const f16x8 raw = *(const f16x8*)(dst + off);
                    const f32x4 v0 = __builtin_convertvector(__builtin_shufflevector(raw, raw, 0, 1, 2, 3), f32x4), v1 = __builtin_convertvector(__builtin_shufflevector(raw, raw, 4, 5, 6, 7), f32x4);
                    const f32x4 r0 = ((v0 - stv.x) * stv.y * lgv0 + lbv0) * alpha + gv0 * acc[ai][bj][m][0];
                    const f32x4 r1 = ((v1 - stv.x) * stv.y * lgv1 + lbv1) * alpha + gv1 * acc[ai][bj][m][1];
                    const f16x4 h0 = __builtin_convertvector(r0, f16x4), h1 = __builtin_convertvector(r1, f16x4);
                    const f16x8 rh_ = __builtin_shufflevector(h0, h1, 0, 1, 2, 3, 4, 5, 6, 7); if (!dry) *(f16x8*)(dst + off) = rh_; else asm volatile("" :: "v"(rh_)); }
                asm volatile("" ::: "memory"); } }
    }
};
struct EpiGate {
    static constexpr bool PERM = true, AFTER_DRAIN = false;
    bf16_t* ACCF; bf16_t* ACCP0; bf16_t* ACCP1; const bf16_t* U; const float* bias; int first; int lastb; int dry;
    __device__ __forceinline__ void operator()(const f32x4 (&acc)[2][2][4][2], const Unit& u, int wr, int wc, int fr, int fq) const {
        const int row0 = u.pm * BM + wr * 64 + fr, col0 = u.pn * BM + wc * 32 + 8 * fq;
        const int t = ((wr * 4 + wc) * 64) + fq * 16 + fr, k = u.pm * 8 + u.pn;
        const bf16_t* ub = U + (size_t)k * 65536 + t * 8;
        bf16_t* pb = (k < 544 ? ACCP0 + (size_t)k * 65536 : ACCP1 + (size_t)(k - 544) * 65536) + t * 8;
        f32x4 bv[2][2];
#pragma unroll
        for (int bj = 0; bj < 2; ++bj)
#pragma unroll
            for (int n = 0; n < 2; ++n) bv[bj][n] = *(const f32x4*)(bias + col0 + bj * HALF + 4 * n);
        const bool lz = lastb != 0; const unsigned keep = first ? 0u : 0xffffffffu;
        const int oSA = lz ? HALF * 2048 : 8 * 4096, oSM = lz ? 16 * 2048 : 2 * 4096, oSB = lz ? HALF : 4096; bf16_t* ob0 = lz ? ACCF + (size_t)row0 * 2048 + col0 : pb;
#pragma unroll
        for (int ai = 0; ai < 2; ++ai) { if (u.half && u.half != ai + 1) continue;
            u32x4 uq[4][2], pq[4][2];
#pragma unroll
            for (int m = 0; m < 4; ++m)
#pragma unroll
                for (int bj = 0; bj < 2; ++bj) { const int off = ((ai * 4 + m) * 2 + bj) * 4096; uq[m][bj] = *(const u32x4*)(ub + off); pq[m][bj] = *(const u32x4*)(pb + off); }
#pragma unroll
            for (int m = 0; m < 4; ++m)
#pragma unroll
                for (int bj = 0; bj < 2; ++bj) {
                    const u32x4 uv = uq[m][bj]; u32x4 pv = pq[m][bj]; pv.x &= keep; pv.y &= keep; pv.z &= keep; pv.w &= keep;
                    const f32x4 g0 = acc[ai][bj][m][0] + bv[bj][0], g1 = acc[ai][bj][m][1] + bv[bj][1];
                    float o[8];
                    o[0] = bf_lo(pv.x) + fast_sigmoid(g0[0]) * bf_lo(uv.x); o[1] = bf_hi(pv.x) + fast_sigmoid(g0[1]) * bf_hi(uv.x);
                    o[2] = bf_lo(pv.y) + fast_sigmoid(g0[2]) * bf_lo(uv.y); o[3] = bf_hi(pv.y) + fast_sigmoid(g0[3]) * bf_hi(uv.y);
                    o[4] = bf_lo(pv.z) + fast_sigmoid(g1[0]) * bf_lo(uv.z); o[5] = bf_hi(pv.z) + fast_sigmoid(g1[1]) * bf_hi(uv.z);
                    o[6] = bf_lo(pv.w) + fast_sigmoid(g1[2]) * bf_lo(uv.w); o[7] = bf_hi(pv.w) + fast_sigmoid(g1[3]) * bf_hi(uv.w);
                    u32x4 w; w.x = cvt_pk_bf16(o[0], o[1]); w.y = cvt_pk_bf16(o[2], o[3]); w.z = cvt_pk_bf16(o[4], o[5]); w.w = cvt_pk_bf16(o[6], o[7]);
                    if (!dry) *(u32x4*)(ob0 + (ai * oSA + m * oSM + bj * oSB)) = w; else asm volatile("" :: "v"(w)); }
            asm volatile("" ::: "memory"); }
    }
};

template <class Epi, class Sched, bool ALIGN_EPI = false, bool SP2 = false>
__device__ __forceinline__ void gemm_phase(PG8_LAS unsigned char* lds, const Gemm g, const Sched& S, const Epi& E) {
    int tid_ = threadIdx.x; asm volatile("" : "+v"(tid_));
    float zz_ = 0.f; asm volatile("" : "+v"(zz_));
    const int tid = tid_, wid = __builtin_amdgcn_readfirstlane(tid >> 6), lane = tid & 63, wr = wid >> 2, wc = wid & 3, fr = lane & 15, fq = lane >> 4;
    const int K = g.K, nt = K / BK;
    unsigned voffA[2], voffB[2];
#pragma unroll
    for (int i = 0; i < 2; ++i) { int R, C; stage_rc(tid * 16 + i * 8192, R, C); const int Rb = Epi::PERM ? ((R & ~31) + perm32(R & 31)) : R;
        voffA[i] = (unsigned)(R * g.lda + C) * 2u; voffB[i] = (unsigned)(Rb * K + C) * 2u; }
    const size_t kstep = (size_t)(BK * 2);
    const size_t hstepB = (size_t)HALF * K * 2, hstepA = (size_t)HALF * g.lda * 2;
    const size_t tstepB = 2 * hstepB, tstepA = 2 * hstepA;
    const unsigned ldsw = (unsigned)wid * 1024u;
    const int aoff = lds_byte(wr * 64 + fr, fq * 8), boff = lds_byte(wc * 32 + fr, fq * 8);
#define PG8_SA(b, h) (((b) * 2 + (h)) * HTB)
#define PG8_SB(b, h) ((4 + (b) * 2 + (h)) * HTB)
#define PG8_STAGE(bufoff, gbase, voff) do { _Pragma("unroll") for (int _i = 0; _i < 2; ++_i) \
        __builtin_amdgcn_global_load_lds((const unsigned*)((const char*)(gbase) + (voff)[_i]), (PG8_LAS unsigned*)(lds + (bufoff) + ldsw + _i * 8192), 16, 0, 0); } while (0)
#define PG8_LDA(dst, b, h) do { _Pragma("unroll") for (int m = 0; m < 4; ++m) _Pragma("unroll") for (int k = 0; k < 2; ++k) dst[m][k] = *(const PG8_LAS bf16x8*)(lds + PG8_SA(b, h) + aoff + m * 2048 + k * 1024); } while (0)
#define PG8_LDB(dst, b, h) do { _Pragma("unroll") for (int n = 0; n < 2; ++n) _Pragma("unroll") for (int k = 0; k < 2; ++k) dst[n][k] = *(const PG8_LAS bf16x8*)(lds + PG8_SB(b, h) + boff + n * 2048 + k * 1024); } while (0)
#define PG8_MMA(ai, bj, At, Bt) do { __builtin_amdgcn_s_setprio(1); _Pragma("unroll") for (int m = 0; m < 4; ++m) _Pragma("unroll") for (int n = 0; n < 2; ++n) _Pragma("unroll") for (int k = 0; k < 2; ++k) \
        acc[ai][bj][m][n] = __builtin_amdgcn_mfma_f32_16x16x32_bf16(Bt[n][k], At[m][k], acc[ai][bj][m][n], 0, 0, 0); __builtin_amdgcn_s_setprio(0); } while (0)
#define PG8_WAIT_V(n) asm volatile("s_waitcnt vmcnt(" #n ")" ::: "memory")
#define PG8_WAIT_L(n) asm volatile("s_waitcnt lgkmcnt(" #n ")" ::: "memory")
#define PG8_BAR __builtin_amdgcn_s_barrier()
#define PG8_SCHED __builtin_amdgcn_sched_barrier(0)
    Unit cur, nxt; int ui = 0;
    if (!S.next(0, cur)) return;
    f32x4 acc[2][2][4][2];
#pragma unroll
    for (int a = 0; a < 2; ++a)
#pragma unroll
        for (int b = 0; b < 2; ++b)
#pragma unroll
            for (int m = 0; m < 4; ++m)
#pragma unroll
                for (int n = 0; n < 2; ++n) acc[a][b][m][n] = (f32x4){zz_, zz_, zz_, zz_};
    bf16x8 At[4][2], B0[2][2], B1[2][2];
    const char* cA = (const char*)g.A + (size_t)cur.pm * tstepA; const char* cB = (const char*)g.Bt + (size_t)cur.pn * tstepB;
    S.a_ready(cur);
    if constexpr (SP2) {
        PG8_STAGE(PG8_SB(0, 0), cB, voffB); PG8_STAGE(PG8_SB(0, 1), cB + hstepB, voffB); PG8_STAGE(PG8_SA(0, 0), cA, voffA); PG8_STAGE(PG8_SA(0, 1), cA + hstepA, voffA);
        if (wr == 1) PG8_BAR;
        PG8_WAIT_V(2); PG8_BAR;
        PG8_STAGE(PG8_SB(1, 0), cB + kstep, voffB); PG8_STAGE(PG8_SA(1, 0), cA + kstep, voffA); PG8_STAGE(PG8_SB(1, 1), cB + hstepB + kstep, voffB);
        PG8_WAIT_V(6); PG8_BAR;
    } else {
        PG8_STAGE(PG8_SB(0, 0), cB, voffB); PG8_STAGE(PG8_SA(0, 0), cA, voffA); PG8_STAGE(PG8_SB(0, 1), cB + hstepB, voffB); PG8_STAGE(PG8_SA(0, 1), cA + hstepA, voffA);
        if (wr == 1) PG8_BAR;
        PG8_WAIT_V(4); PG8_BAR;
        PG8_STAGE(PG8_SB(1, 0), cB + kstep, voffB); PG8_STAGE(PG8_SA(1, 0), cA + kstep, voffA); PG8_STAGE(PG8_SB(1, 1), cB + hstepB + kstep, voffB);
        PG8_WAIT_V(6); PG8_BAR;
    }
    for (;;) {
        const bool has_next = S.next(ui + 1, nxt);
        const char* nA = has_next ? (const char*)g.A + (size_t)nxt.pm * tstepA : cA; const char* nB = has_next ? (const char*)g.Bt + (size_t)nxt.pn * tstepB : cB;
        if (cur.half == 0) {
        for (int t = 0; t < nt; t += 2) {
            const bool last = (t == nt - 2);
            const char* a1 = cA + (size_t)(t + 1) * kstep;
            const char* a2 = last ? nA : cA + (size_t)(t + 2) * kstep; const char* b2 = last ? nB : cB + (size_t)(t + 2) * kstep;
            const char* a3 = a2 + kstep; const char* b3 = b2 + kstep;
            if (last && has_next) S.a_ready(nxt);
            if constexpr (SP2) {
            PG8_LDB(B0, 0, 0); PG8_LDB(B1, 0, 1); PG8_SCHED; PG8_LDA(At, 0, 0); PG8_STAGE(PG8_SA(1, 1), a1 + hstepA, voffA);
            PG8_WAIT_V(8); PG8_WAIT_L(0); PG8_BAR; PG8_MMA(0, 0, At, B0); PG8_MMA(0, 1, At, B1); PG8_BAR; PG8_SCHED;
            PG8_LDA(At, 0, 1); PG8_STAGE(PG8_SB(0, 0), b2, voffB); PG8_STAGE(PG8_SB(0, 1), b2 + hstepB, voffB); PG8_STAGE(PG8_SA(0, 0), a2, voffA);
            PG8_WAIT_V(8); PG8_WAIT_L(0); PG8_BAR; PG8_MMA(1, 0, At, B0); PG8_MMA(1, 1, At, B1); PG8_BAR; PG8_SCHED;
            PG8_LDB(B0, 1, 0); PG8_LDB(B1, 1, 1); PG8_SCHED; PG8_LDA(At, 1, 0); PG8_STAGE(PG8_SA(0, 1), a2 + hstepA, voffA);
            PG8_WAIT_V(8); PG8_WAIT_L(0); PG8_BAR; PG8_MMA(0, 0, At, B0); PG8_MMA(0, 1, At, B1); PG8_BAR; PG8_SCHED;
            PG8_LDA(At, 1, 1); PG8_STAGE(PG8_SB(1, 0), b3, voffB); PG8_STAGE(PG8_SB(1, 1), b3 + hstepB, voffB); PG8_STAGE(PG8_SA(1, 0), a3, voffA);
            PG8_WAIT_V(8); PG8_WAIT_L(0); PG8_BAR; PG8_MMA(1, 0, At, B0); PG8_MMA(1, 1, At, B1); PG8_BAR; PG8_SCHED;
            } else {
            PG8_LDB(B0, 0, 0); PG8_SCHED; PG8_LDA(At, 0, 0); PG8_STAGE(PG8_SA(1, 1), a1 + hstepA, voffA);
            PG8_WAIT_L(8); PG8_BAR; PG8_WAIT_L(0); PG8_MMA(0, 0, At, B0); PG8_BAR; PG8_SCHED;
            PG8_LDB(B1, 0, 1); PG8_STAGE(PG8_SB(0, 0), b2, voffB);
            PG8_BAR; PG8_WAIT_L(0); PG8_MMA(0, 1, At, B1); PG8_BAR;
            PG8_LDA(At, 0, 1); PG8_STAGE(PG8_SA(0, 0), a2, voffA);
            PG8_BAR; PG8_WAIT_L(0); PG8_MMA(1, 0, At, B0); PG8_BAR; PG8_SCHED;
            PG8_STAGE(PG8_SB(0, 1), b2 + hstepB, voffB);
            PG8_WAIT_V(6); PG8_BAR; PG8_MMA(1, 1, At, B1); PG8_BAR;
            PG8_LDB(B0, 1, 0); PG8_SCHED; PG8_LDA(At, 1, 0); PG8_STAGE(PG8_SA(0, 1), a2 + hstepA, voffA);
            PG8_WAIT_L(8); PG8_BAR; PG8_WAIT_L(0); PG8_MMA(0, 0, At, B0); PG8_BAR; PG8_SCHED;
            PG8_LDB(B1, 1, 1); PG8_STAGE(PG8_SB(1, 0), b3, voffB);
            PG8_BAR; PG8_WAIT_L(0); PG8_MMA(0, 1, At, B1); PG8_BAR;
            PG8_LDA(At, 1, 1); PG8_STAGE(PG8_SA(1, 0), a3, voffA);
            PG8_BAR; PG8_WAIT_L(0); PG8_MMA(1, 0, At, B0); PG8_BAR; PG8_SCHED;
            PG8_STAGE(PG8_SB(1, 1), b3 + hstepB, voffB);
            PG8_WAIT_V(6); PG8_BAR; PG8_MMA(1, 1, At, B1); PG8_BAR;
            }
        }
        } else {
        for (int t = 0; t < nt; t += 2) {
            const bool last = (t == nt - 2);
            const char* a1 = cA + (size_t)(t + 1) * kstep;
            const char* a2 = last ? nA : cA + (size_t)(t + 2) * kstep; const char* b2 = last ? nB : cB + (size_t)(t + 2) * kstep;
            const char* a3 = a2 + kstep; const char* b3 = b2 + kstep;
            if (last && has_next) S.a_ready(nxt);
            if constexpr (SP2) {
            PG8_LDB(B0, 0, 0); PG8_LDB(B1, 0, 1); PG8_SCHED; PG8_LDA(At, 0, 0); PG8_STAGE(PG8_SA(1, 1), a1 + hstepA, voffA);
            PG8_WAIT_V(8); PG8_WAIT_L(0); PG8_BAR; if (cur.half != 2) { PG8_MMA(0, 0, At, B0); PG8_MMA(0, 1, At, B1); } PG8_BAR; PG8_SCHED;
            PG8_LDA(At, 0, 1); PG8_STAGE(PG8_SB(0, 0), b2, voffB); PG8_STAGE(PG8_SB(0, 1), b2 + hstepB, voffB); PG8_STAGE(PG8_SA(0, 0), a2, voffA);
            PG8_WAIT_V(8); PG8_WAIT_L(0); PG8_BAR; if (cur.half != 1) { PG8_MMA(1, 0, At, B0); PG8_MMA(1, 1, At, B1); } PG8_BAR; PG8_SCHED;
            PG8_LDB(B0, 1, 0); PG8_LDB(B1, 1, 1); PG8_SCHED; PG8_LDA(At, 1, 0); PG8_STAGE(PG8_SA(0, 1), a2 + hstepA, voffA);
            PG8_WAIT_V(8); PG8_WAIT_L(0); PG8_BAR; if (cur.half != 2) { PG8_MMA(0, 0, At, B0); PG8_MMA(0, 1, At, B1); } PG8_BAR; PG8_SCHED;
            PG8_LDA(At, 1, 1); PG8_STAGE(PG8_SB(1, 0), b3, voffB); PG8_STAGE(PG8_SB(1, 1), b3 + hstepB, voffB); PG8_STAGE(PG8_SA(1, 0), a3, voffA);
            PG8_WAIT_V(8); PG8_WAIT_L(0); PG8_BAR; if (cur.half != 1) { PG8_MMA(1, 0, At, B0); PG8_MMA(1, 1, At, B1); } PG8_BAR; PG8_SCHED;
            } else {
            PG8_LDB(B0, 0, 0); PG8_SCHED; PG8_LDA(At, 0, 0); PG8_STAGE(PG8_SA(1, 1), a1 + hstepA, voffA);
            PG8_WAIT_L(8); PG8_BAR; PG8_WAIT_L(0); PG8_MMA(0, 0, At, B0); PG8_BAR; PG8_SCHED;
            PG8_LDB(B1, 0, 1); PG8_STAGE(PG8_SB(0, 0), b2, voffB);
            PG8_BAR; PG8_WAIT_L(0); PG8_MMA(0, 1, At, B1); PG8_BAR;
            PG8_LDA(At, 0, 1); PG8_STAGE(PG8_SA(0, 0), a2, voffA);
            PG8_BAR; PG8_WAIT_L(0); PG8_MMA(1, 0, At, B0); PG8_BAR; PG8_SCHED;
            PG8_STAGE(PG8_SB(0, 1), b2 + hstepB, voffB);
            PG8_WAIT_V(6); PG8_BAR; PG8_MMA(1, 1, At, B1); PG8_BAR;
            PG8_LDB(B0, 1, 0); PG8_SCHED; PG8_LDA(At, 1, 0); PG8_STAGE(PG8_SA(0, 1), a2 + hstepA, voffA);
            PG8_WAIT_L(8); PG8_BAR; PG8_WAIT_L(0); PG8_MMA(0, 0, At, B0); PG8_BAR; PG8_SCHED;
            PG8_LDB(B1, 1, 1); PG8_STAGE(PG8_SB(1, 0), b3, voffB);
            PG8_BAR; PG8_WAIT_L(0); PG8_MMA(0, 1, At, B1); PG8_BAR;
            PG8_LDA(At, 1, 1); PG8_STAGE(PG8_SA(1, 0), a3, voffA);
            PG8_BAR; PG8_WAIT_L(0); PG8_MMA(1, 0, At, B0); PG8_BAR; PG8_SCHED;
            PG8_STAGE(PG8_SB(1, 1), b3 + hstepB, voffB);
            PG8_WAIT_V(6); PG8_BAR; PG8_MMA(1, 1, At, B1); PG8_BAR;
            }
        }
        }
        if constexpr (ALIGN_EPI) { if (wr == 0) PG8_BAR; }
        if constexpr (!Epi::AFTER_DRAIN) { E(acc, cur, wr, wc, fr, fq); S.done(cur); }
        if (!has_next) break;
#pragma unroll
        for (int a = 0; a < 2; ++a)
#pragma unroll
            for (int b = 0; b < 2; ++b)
#pragma unroll
                for (int m = 0; m < 4; ++m)
#pragma unroll
                    for (int n = 0; n < 2; ++n) acc[a][b][m][n] = (f32x4){zz_, zz_, zz_, zz_};
        cur = nxt; cA = nA; cB = nB; ++ui;
        if constexpr (ALIGN_EPI) { if (wr == 1) PG8_BAR; }
    }
    PG8_WAIT_V(0);
    if constexpr (!ALIGN_EPI) { if (wr == 0) PG8_BAR; }
    PG8_BAR;
    if constexpr (Epi::AFTER_DRAIN) { E.fused(acc, cur, wr, wc, fr, fq, lds, wid, lane); S.done(cur); }
#undef PG8_SA
#undef PG8_SB
#undef PG8_STAGE
#undef PG8_LDA
#undef PG8_LDB
#undef PG8_MMA
#undef PG8_WAIT_V
#undef PG8_WAIT_L
#undef PG8_BAR
#undef PG8_SCHED
}
}

namespace att {
typedef unsigned short bf16;
using bf16x8 = __attribute__((ext_vector_type(8))) short;
using s16x4  = __attribute__((ext_vector_type(4))) short;
using f32x16 = __attribute__((ext_vector_type(16))) float;
using u32x4  = __attribute__((ext_vector_type(4))) unsigned;
constexpr int D = 128, NW = 8, QBLK = 32, KVBLK = 64;
constexpr float SCALE = 0.088388347648318440f;
constexpr float THR = 8.f;
#ifndef ATT_SDEPTH
#define ATT_SDEPTH 1
#endif
constexpr int LDZ = 4864;
constexpr size_t SHM_V = KVBLK * D * 2, SHM_K = KVBLK * D * 2, SHM_ATTN = 2 * SHM_V + 2 * SHM_K + NW * 64 * 4;
#define KSWZ(row, colB) ((row) * 256 + ((colB) ^ (((row) & 7) << 4)))
#define SBAR() __builtin_amdgcn_sched_barrier(0)
__device__ __forceinline__ int crow(int r, int hi) { return (r & 3) + 8 * (r >> 2) + 4 * hi; }
__device__ __forceinline__ unsigned cvtpk(float lo, float hi) { unsigned r; asm volatile("v_cvt_pk_bf16_f32 %0, %1, %2" : "=v"(r) : "v"(lo), "v"(hi)); return r; }

__device__ __forceinline__ void band_mask(f32x16& p0, f32x16& p1, int rel0, int hi) {
#pragma unroll
    for (int r = 0; r < 16; ++r) { const int d0 = rel0 + crow(r, hi), d1 = d0 + 32;
        if (d0 > 128 || d0 < -128) p0[r] = -1e30f;
        if (d1 > 128 || d1 < -128) p1[r] = -1e30f; }
}
__device__ __forceinline__ void partialSM(f32x16& p0, f32x16& p1, float& m_reg, float& mn, float& alpha) {
    constexpr float C = SCALE * 1.4426950408889634f;
    float pmax = p0[0];
#pragma unroll
    for (int r = 1; r < 16; ++r) pmax = fmaxf(pmax, p0[r]);
#pragma unroll
    for (int r = 0; r < 16; ++r) pmax = fmaxf(pmax, p1[r]);
    { auto rr = __builtin_amdgcn_permlane32_swap(__float_as_uint(pmax), __float_as_uint(pmax), false, false);
      pmax = fmaxf(__uint_as_float(rr[0]), __uint_as_float(rr[1])); }
    if (__builtin_expect(__all(pmax - m_reg <= THR / SCALE), 1)) { mn = m_reg; alpha = 1.f; }
    else { mn = fmaxf(m_reg, pmax); alpha = __builtin_amdgcn_exp2f((m_reg - mn) * C); m_reg = mn; }
    float mnC = -mn * C;
#pragma unroll
    for (int r = 0; r < 16; ++r) p0[r] = fmaf(p0[r], C, mnC);
#pragma unroll
    for (int r = 0; r < 16; ++r) p1[r] = fmaf(p1[r], C, mnC);
#pragma unroll
    for (int r = 0; r < 16; ++r) p0[r] = __builtin_amdgcn_exp2f(p0[r]);
}
__device__ __forceinline__ void finishSM(f32x16& p0, f32x16& p1, float alpha, float& l_reg, bf16x8& pa0, bf16x8& pa1, bf16x8& pa2, bf16x8& pa3) {
#pragma unroll
    for (int r = 0; r < 16; ++r) p1[r] = __builtin_amdgcn_exp2f(p1[r]);
    float ps = 0;
#pragma unroll
    for (int r = 0; r < 16; ++r) ps += p0[r];
#pragma unroll
    for (int r = 0; r < 16; ++r) ps += p1[r];
    { auto rr = __builtin_amdgcn_permlane32_swap(__float_as_uint(ps), __float_as_uint(ps), false, false);
      ps = __uint_as_float(rr[0]) + __uint_as_float(rr[1]); }
    l_reg = l_reg * alpha + ps;
#define PK4(P, BASE, OUT) do { unsigned a0 = cvtpk(P[BASE + 0], P[BASE + 1]), a1 = cvtpk(P[BASE + 2], P[BASE + 3]);   \
    unsigned b0 = cvtpk(P[BASE + 4], P[BASE + 5]), b1 = cvtpk(P[BASE + 6], P[BASE + 7]);                              \
    auto r0 = __builtin_amdgcn_permlane32_swap(a0, b0, false, false); auto r1 = __builtin_amdgcn_permlane32_swap(a1, b1, false, false); \
    u32x4 w = {r0[0], r1[0], r0[1], r1[1]}; OUT = *reinterpret_cast<bf16x8*>(&w); } while (0)
    PK4(p0, 0, pa0); PK4(p0, 8, pa1); PK4(p1, 0, pa2); PK4(p1, 8, pa3);
#undef PK4
}
__device__ __forceinline__ void qkt(f32x16& p0, f32x16& p1, const bf16* Ks, const bf16x8* qr, int r32, int hi) {
    p0 = f32x16{}; p1 = f32x16{};
#pragma unroll
    for (int d0 = 0; d0 < 8; ++d0) { int cb = (d0 * 16 + hi * 8) * 2;
        bf16x8 b0 = *reinterpret_cast<const bf16x8*>((const char*)Ks + KSWZ(r32, cb));
        bf16x8 b1 = *reinterpret_cast<const bf16x8*>((const char*)Ks + KSWZ(32 + r32, cb));
        p0 = __builtin_amdgcn_mfma_f32_32x32x16_bf16(b0, qr[d0], p0, 0, 0, 0);
        p1 = __builtin_amdgcn_mfma_f32_32x32x16_bf16(b1, qr[d0], p1, 0, 0, 0); }
}
__device__ __forceinline__ int v_st(int k, int c) { const int kk = (k & ~0xC) | ((k & 4) << 1) | ((k & 8) >> 1); return ((kk >> 3) * 4 + (c >> 5)) * 512 + ((kk & 7) * 32 + (c & 31)) * 2; }
__device__ __forceinline__ int v_rd_base(int lane) { return ((lane & 3) << 3) | (((lane >> 2) & 3) << 6) | (((lane >> 4) & 1) << 5) | (((lane >> 5) & 1) << 8); }
constexpr int v_rd_off(int d0, int ks, int half) { return d0 * 512 + ks * 4096 + half * 2048; }
template <int OFF> __device__ __forceinline__ s16x4 tr_read(int vb) {
    s16x4 r; asm volatile("ds_read_b64_tr_b16 %0, %1 offset:%2" : "=&v"(r) : "v"(vb), "i"(OFF) : "memory"); return r;
}
template <int D0> __device__ __forceinline__ void pv_one(f32x16& od, int vb, bf16x8 pa0, bf16x8 pa1, bf16x8 pa2, bf16x8 pa3) {
    const s16x4 l0 = tr_read<v_rd_off(D0, 0, 0)>(vb), h0 = tr_read<v_rd_off(D0, 0, 1)>(vb), l1 = tr_read<v_rd_off(D0, 1, 0)>(vb), h1 = tr_read<v_rd_off(D0, 1, 1)>(vb);
    const s16x4 l2 = tr_read<v_rd_off(D0, 2, 0)>(vb), h2 = tr_read<v_rd_off(D0, 2, 1)>(vb), l3 = tr_read<v_rd_off(D0, 3, 0)>(vb), h3 = tr_read<v_rd_off(D0, 3, 1)>(vb);
    asm volatile("s_waitcnt lgkmcnt(0)" ::: "memory"); SBAR();
#define PK(L, H) (bf16x8){L[0], L[1], L[2], L[3], H[0], H[1], H[2], H[3]}
    od = __builtin_amdgcn_mfma_f32_32x32x16_bf16(pa0, PK(l0, h0), od, 0, 0, 0);
    od = __builtin_amdgcn_mfma_f32_32x32x16_bf16(pa1, PK(l1, h1), od, 0, 0, 0);
    od = __builtin_amdgcn_mfma_f32_32x32x16_bf16(pa2, PK(l2, h2), od, 0, 0, 0);
    od = __builtin_amdgcn_mfma_f32_32x32x16_bf16(pa3, PK(l3, h3), od, 0, 0, 0);
#undef PK
}
__device__ __forceinline__ void pv_d0(f32x16* o, int vb, bf16x8 pa0, bf16x8 pa1, bf16x8 pa2, bf16x8 pa3) {
    pv_one<0>(o[0], vb, pa0, pa1, pa2, pa3); pv_one<1>(o[1], vb, pa0, pa1, pa2, pa3); pv_one<2>(o[2], vb, pa0, pa1, pa2, pa3); pv_one<3>(o[3], vb, pa0, pa1, pa2, pa3);
}

__device__ __forceinline__ void attn_body(const bool BAND, const bf16* __restrict__ Qb, const bf16* __restrict__ Kh, const bf16* __restrict__ Vh, bf16* __restrict__ Ob,
                                          int NT, int bstart, int qpos0, float m0, float l0, char* lds, const int dry) {
    int tid_ = threadIdx.x; asm volatile("" : "+v"(tid_));
    const int tid = tid_, wid = tid >> 6, lane = tid & 63, r32 = lane & 31, hi = lane >> 5;
    bf16* V_lds = (bf16*)lds; bf16* K_lds = (bf16*)(lds + 2 * SHM_V);
    float* ws = (float*)(lds + 2 * SHM_V + 2 * SHM_K) + wid * 64; float* li_l = ws; float* al_l = ws + 32;
    float m_reg = m0, l_reg = l0; f32x16 o[4] = {}; bf16x8 qr[8];
    const bf16* Qw = Qb + (long)(wid * QBLK + r32) * LDZ + hi * 8;
#pragma unroll
    for (int d0 = 0; d0 < 8; ++d0) qr[d0] = *reinterpret_cast<const bf16x8*>(Qw + d0 * 16);
    const int sr = tid >> 4, sc = (tid & 15) * 8, vst0 = v_st(sr, sc), vst1 = v_st(32 + sr, sc);
    const int vb0 = (int)(uintptr_t)V_lds + v_rd_base(lane);
    const int qrel = qpos0 + wid * QBLK + r32;
    constexpr int SDEPTH = ATT_SDEPTH;
    struct { bf16x8 vs0, vs1, ks0, ks1; } sr_[SDEPTH];
#define KROW(t) ((BAND && (t) >= 4) ? (256 + bstart + ((t) - 4) * KVBLK) : (t) * KVBLK)
#define SLOAD(i, t) do { const int k0_ = KROW(t); sr_[i].vs0 = *reinterpret_cast<const bf16x8*>(&Vh[(long)(k0_ + sr) * LDZ + sc]); sr_[i].vs1 = *reinterpret_cast<const bf16x8*>(&Vh[(long)(k0_ + 32 + sr) * LDZ + sc]); \
    sr_[i].ks0 = *reinterpret_cast<const bf16x8*>(&Kh[(long)(k0_ + sr) * LDZ + sc]); sr_[i].ks1 = *reinterpret_cast<const bf16x8*>(&Kh[(long)(k0_ + 32 + sr) * LDZ + sc]); } while (0)
#define SWRITE(b, i) do { *(bf16x8*)((char*)V_lds + (b) * SHM_V + vst0) = sr_[i].vs0;          \
    *(bf16x8*)((char*)V_lds + (b) * SHM_V + vst1) = sr_[i].vs1; int kc = sc * 2;               \
    *(bf16x8*)((char*)K_lds + (b) * SHM_K + KSWZ(sr, kc)) = sr_[i].ks0;                       \
    *(bf16x8*)((char*)K_lds + (b) * SHM_K + KSWZ(32 + sr, kc)) = sr_[i].ks1; } while (0)
#define SWAIT() do { if constexpr (SDEPTH == 2) asm volatile("s_waitcnt vmcnt(4)" ::: "memory"); else asm volatile("s_waitcnt vmcnt(0)" ::: "memory"); } while (0)
#define RESC(a) do { if (__any((a) < 1.f)) { if (hi == 0) al_l[r32] = (a); asm volatile("s_waitcnt lgkmcnt(0)" ::: "memory"); \
    _Pragma("unroll") for (int d = 0; d < 4; ++d) _Pragma("unroll") for (int r = 0; r < 16; ++r) o[d][r] *= al_l[crow(r, hi)]; } } while (0)
#define MASK(P0, P1, t) do { if (BAND && (t) >= 4) band_mask(P0, P1, bstart + ((t) - 4) * KVBLK - qrel, hi); } while (0)
    f32x16 pA0, pA1, pB0, pB1; float mnA, mnB, alA, alB; bf16x8 pa0, pa1, pa2, pa3;
    constexpr int SE = 0, SO = SDEPTH - 1;
    SLOAD(SE, 0); asm volatile("s_waitcnt vmcnt(0)" ::: "memory"); SWRITE(0, SE); __syncthreads();
    qkt(pA0, pA1, K_lds, qr, r32, hi); MASK(pA0, pA1, 0); partialSM(pA0, pA1, m_reg, mnA, alA);
    SLOAD(SO, 1); if constexpr (SDEPTH == 2) { if (2 < NT) SLOAD(SE, 2); }
    SWAIT(); SWRITE(1, SO); __syncthreads();
    for (int j = 1; j + 1 < NT; j += 2) {
        SBAR(); qkt(pB0, pB1, (bf16*)((char*)K_lds + SHM_K), qr, r32, hi); MASK(pB0, pB1, j);
        finishSM(pA0, pA1, alA, l_reg, pa0, pa1, pa2, pa3); SBAR();
        SLOAD(SO, j + SDEPTH); SBAR();
        pv_d0(o, vb0, pa0, pa1, pa2, pa3); partialSM(pB0, pB1, m_reg, mnB, alB);
        __syncthreads(); SWAIT(); SWRITE(0, SE);
        RESC(alB); __syncthreads();
        SBAR(); qkt(pA0, pA1, K_lds, qr, r32, hi); MASK(pA0, pA1, j + 1);
        finishSM(pB0, pB1, alB, l_reg, pa0, pa1, pa2, pa3); SBAR();
        if (SDEPTH == 1 || j + 3 < NT) SLOAD(SE, j + 1 + SDEPTH); SBAR();
        pv_d0(o, vb0 + (int)SHM_V, pa0, pa1, pa2, pa3); partialSM(pA0, pA1, m_reg, mnA, alA);
        __syncthreads(); SWAIT(); SWRITE(1, SO);
        RESC(alA); __syncthreads();
    }
    SBAR(); qkt(pB0, pB1, (bf16*)((char*)K_lds + SHM_K), qr, r32, hi); MASK(pB0, pB1, NT - 1);
    finishSM(pA0, pA1, alA, l_reg, pa0, pa1, pa2, pa3); SBAR();
    pv_d0(o, vb0, pa0, pa1, pa2, pa3); partialSM(pB0, pB1, m_reg, mnB, alB);
    __syncthreads(); RESC(alB);
    finishSM(pB0, pB1, alB, l_reg, pa0, pa1, pa2, pa3); SBAR();
    pv_d0(o, vb0 + (int)SHM_V, pa0, pa1, pa2, pa3);
    if (hi == 0) li_l[r32] = l_reg; asm volatile("s_waitcnt lgkmcnt(0)" ::: "memory");
    float rli[16];
#pragma unroll
    for (int r = 0; r < 16; ++r) rli[r] = __builtin_amdgcn_rcpf(li_l[crow(r, hi)]);
    bf16* Ow = Ob + (long)(wid * QBLK) * LDZ;
#pragma unroll
    for (int r = 0; r < 16; ++r) { const int orow = crow(r, hi);
#pragma unroll
        for (int d0 = 0; d0 < 4; d0 += 2) { const unsigned w = cvtpk(o[d0][r] * rli[r], o[d0 + 1][r] * rli[r]);
            if (!dry) { Ow[(long)orow * LDZ + d0 * 32 + r32] = (bf16)(w & 0xffffu); Ow[(long)orow * LDZ + (d0 + 1) * 32 + r32] = (bf16)(w >> 16); } else asm volatile("" :: "v"(w)); } }
    __syncthreads();
#undef KROW
#undef SLOAD
#undef SWRITE
#undef SWAIT
#undef RESC
#undef MASK
}
#undef KSWZ
#undef SBAR
}

constexpr int DM = 2048, NBATCH = 8, SEQ = 4096, CTXL = 256, SA = 4352, TOK = NBATCH * SA, NPAN = TOK / 256, DFF = 5632;
constexpr int NZ = 4864;
constexpr int ZC_POOL = 0, ZC_RWKV = 512, ZC_WIN = 2688, ZC_DENSE = 3712, ZC_PAD = 4736;
constexpr int INW = 12928;
constexpr int NMOD = 9 * DM;
constexpr float LN_EPS = 1e-6f, RMS_EPS = 1e-6f, GN_EPS = 64e-5f;
constexpr float DN_ALPHA = 1.4142135623730951f;

constexpr size_t MiB = 1u << 20;
constexpr size_t WS_CTL = 0, CTL_ZERO_BYTES = 64 * 1024;
constexpr size_t WS_ROPE = 1 * MiB;
constexpr size_t WS_MOD = 2 * MiB;
constexpr size_t WS_STATS = 3584 * 1024;
constexpr size_t WS_IDLN = 3904 * 1024;
constexpr size_t WS_WB = 4 * MiB;
constexpr size_t WS_X = 76 * MiB;
constexpr size_t WS_BON = (76 + 136) * MiB;
constexpr size_t WS_WB2 = (76 + 140) * MiB;
constexpr size_t WS_WB4 = (76 + 206) * MiB;
constexpr size_t WS_H = 348 * MiB;
constexpr size_t WS_R = 484 * MiB;
constexpr size_t PLANE = (size_t)TOK * 512 * 2;
constexpr size_t R_MID = 0;
constexpr size_t R_MODP = 0;
constexpr size_t R_Z = 0;
constexpr size_t R_POOL = 323 * MiB, R_O0 = R_POOL + PLANE, R_O1 = R_O0 + PLANE, R_RWR = R_O1 + PLANE;
constexpr size_t R_RWK = R_RWR + PLANE, R_RWV = R_RWK + PLANE, R_RWKK = R_RWV + PLANE, R_RWA0 = R_RWKK + PLANE, R_RWA1 = R_RWA0 + PLANE, R_RWG = R_RWA1 + PLANE;
constexpr size_t R_RWW0 = R_RWG + PLANE, R_RWW1 = R_RWW0 + 2 * PLANE;
constexpr size_t R_UBUF = R_RWW0, R_ACC = R_RWK;
constexpr size_t R_END = R_RWW1 + 2 * PLANE;
constexpr size_t WS_END = WS_R + R_END;
static_assert(R_UBUF + 4 * PLANE <= R_END && R_ACC + 4 * PLANE <= R_RWA1 + PLANE && PLANE == 34 * MiB && (size_t)TOK * NZ * 2 <= R_POOL && (size_t)TOK * DFF * 2 <= R_END, "workspace map");
constexpr size_t WB_WI = 0, WB_WO = (size_t)2 * DFF * DM * 2;
constexpr size_t WB_WIN = 0, WB_WG = (size_t)NZ * DM * 2, WB_WUP = WB_WG + (size_t)8192 * DM * 2, WB_WOUT = WB_WUP + (size_t)4 * DM * 512 * 2;
constexpr size_t WB_POOLW = WB_WOUT + (size_t)DM * DM * 2, WB_W2T = WB_POOLW + 4 * 128 * 128 * 2, WB_A2T = WB_W2T + 2 * 512 * 96 * 2, WB_G2T = WB_A2T + 2 * 512 * 96 * 2, WB_MIX_END = WB_G2T + 512 * 256 * 2;
static_assert(WB_MIX_END <= 72 * MiB && WB_WO + (size_t)DM * DFF * 2 <= 72 * MiB, "weight buffer");

constexpr int RING_BYTES = 131072;
constexpr int LDSCTL_OFF = RING_BYTES, MISC_OFF = LDSCTL_OFF + 320;
constexpr int LDS_BYTES = 147456;
constexpr int NWAVES = 8, NTHR = 512;

#define GAS __attribute__((address_space(1)))
#define LAS __attribute__((address_space(3)))
typedef unsigned short bf16;
typedef unsigned v4u __attribute__((ext_vector_type(4)));
typedef unsigned v2u __attribute__((ext_vector_type(2)));
typedef float f32x4 __attribute__((ext_vector_type(4)));
typedef float f32x16 __attribute__((ext_vector_type(16)));
typedef short bf16x8 __attribute__((ext_vector_type(8)));
#define LDS_WAIT() asm volatile("s_waitcnt lgkmcnt(0)" ::: "memory")

typedef float f32x2_t_ __attribute__((ext_vector_type(2))); typedef __bf16 bf16x2_t_ __attribute__((ext_vector_type(2)));
__device__ __forceinline__ unsigned pk2(float lo, float hi) { const f32x2_t_ v = {lo, hi}; const bf16x2_t_ b = __builtin_convertvector(v, bf16x2_t_); return __builtin_bit_cast(unsigned, b); }
__device__ __forceinline__ unsigned f2bf(float f) { return pk2(f, f) & 0xffffu; }
__device__ __forceinline__ float bflo(unsigned w) { return __uint_as_float(w << 16); }
__device__ __forceinline__ float bfhi(unsigned w) { return __uint_as_float(w & 0xffff0000u); }
__device__ __forceinline__ void unpack8(const v4u w, float (&f)[8]) { f[0] = bflo(w.x); f[1] = bfhi(w.x); f[2] = bflo(w.y); f[3] = bfhi(w.y); f[4] = bflo(w.z); f[5] = bfhi(w.z); f[6] = bflo(w.w); f[7] = bfhi(w.w); }
__device__ __forceinline__ v4u pack8(const float (&f)[8]) { v4u w; w.x = pk2(f[0], f[1]); w.y = pk2(f[2], f[3]); w.z = pk2(f[4], f[5]); w.w = pk2(f[6], f[7]); return w; }
__device__ __forceinline__ float sigmoidf_(float x) { return __builtin_amdgcn_rcpf(1.0f + __expf(-x)); }

#define XB_TMO      128
#define XB_XCNT(j)  (256  + 64 * (j))
#define XB_XSUB(j)  (1280 + 64 * (j))
#define XB_XGEN(j)  (2304 + 64 * (j))
#define XB_TOP      3328
#define XB_TOPGEN   3392
#define XCD_BAR_WORDS 3456
#define XB_SPIN_CAP (1u << 22)

__device__ __forceinline__ unsigned xb_ld(unsigned* p)              { return __hip_atomic_load(p, __ATOMIC_RELAXED, __HIP_MEMORY_SCOPE_AGENT); }
__device__ __forceinline__ unsigned xb_add(unsigned* p, unsigned v) { return __hip_atomic_fetch_add(p, v, __ATOMIC_RELAXED, __HIP_MEMORY_SCOPE_AGENT); }
__device__ __forceinline__ unsigned xb_xcc_id() { return (unsigned)__builtin_amdgcn_s_getreg((3 << 11) | 20) & 0xFu; }
#define XB_SPIN(cond, bar) do { unsigned _sp = 0; while (cond) { __builtin_amdgcn_s_sleep(1); \
    if ((++_sp & 255u) == 0u) { if (xb_ld(&(bar)[XB_TMO])) break; if (_sp > XB_SPIN_CAP) { atomicAdd(&(bar)[XB_TMO], 1u); break; } } } } while (0)

struct XcdBarrier {
    unsigned* bar; unsigned x;
    volatile LAS unsigned* st;
};
__device__ __forceinline__ XcdBarrier xcd_barrier_post(unsigned* bar, volatile LAS unsigned* st) {
    XcdBarrier b; b.bar = bar; b.x = xb_xcc_id(); b.st = st;
    if (threadIdx.x == 0) (void)xb_add(&bar[XB_XCNT(b.x)], 1u);
    return b;
}
__device__ __forceinline__ void xcd_barrier_complete(unsigned* bar, unsigned x, unsigned& nloc, unsigned& nx) {
    const unsigned G = gridDim.x * gridDim.y * gridDim.z;
    unsigned sum, cnt, mine, sp = 0u;
    for (;;) {
        sum = 0u; cnt = 0u; mine = 0u;
#pragma unroll
        for (unsigned j = 0; j < 16; ++j) { const unsigned c = xb_ld(&bar[XB_XCNT(j)]); sum += c; cnt += (c > 0u) ? 1u : 0u; mine = (j == x) ? c : mine; }
        if (sum == G) break;
        __builtin_amdgcn_s_sleep(1);
        if ((++sp & 255u) == 0u) { if (xb_ld(&bar[XB_TMO])) break; if (sp > XB_SPIN_CAP) { atomicAdd(&bar[XB_TMO], 1u); break; } }
    }
    nloc = mine > 0u ? mine : 1u; nx = cnt > 0u ? cnt : 1u;
}
__device__ __forceinline__ void xcd_barrier(const XcdBarrier& b) {
    asm volatile("s_waitcnt vmcnt(0)" ::: "memory");
    __syncthreads();
    if (threadIdx.x == 0) {
        unsigned* bar = b.bar;
        __builtin_amdgcn_s_waitcnt(0);
        unsigned nloc = b.st[0], nx = b.st[1];
        if (nloc == 0u) { xcd_barrier_complete(bar, b.x, nloc, nx); b.st[0] = nloc; b.st[1] = nx; }
        const unsigned old = xb_add(&bar[XB_XSUB(b.x)], 1u);
        const unsigned gen = old / nloc;
        if (old + 1u == (gen + 1u) * nloc) {
            __builtin_amdgcn_fence(__ATOMIC_RELEASE, "agent");
            asm volatile("s_waitcnt vmcnt(0)" ::: "memory");
            const unsigned og = xb_add(&bar[XB_TOP], 1u);
            const unsigned tg = og / nx;
            if (og + 1u == (tg + 1u) * nx) xb_add(&bar[XB_TOPGEN], 1u);
            else XB_SPIN(xb_ld(&bar[XB_TOPGEN]) == tg, bar);
            __builtin_amdgcn_fence(__ATOMIC_ACQUIRE, "agent");
            xb_add(&bar[XB_XGEN(b.x)], 1u);
            asm volatile("s_waitcnt vmcnt(0)" ::: "memory");
        } else {
            XB_SPIN(xb_ld(&bar[XB_XGEN(b.x)]) == gen, bar);
            __builtin_amdgcn_fence(__ATOMIC_ACQUIRE, "agent");
            asm volatile("s_waitcnt vmcnt(0)" ::: "memory");
        }
    }
    __syncthreads();
}

struct Args {
    const float* in[32];
    float* out; unsigned char* ws;
};
enum { I_X = 0, I_C, I_CTX, I_CCTX, I_WMOD, I_BMOD, I_LNG, I_LNB, I_F1WI, I_F1WO, I_F2WI, I_F2WO, I_WIN, I_BGATE, I_POOLW, I_POOLS, I_MU, I_W0, I_W2, I_A0, I_A2, I_G2,
       I_KK, I_KA, I_RK, I_GNG, I_GNB, I_SINK, I_QN, I_KN, I_WUP, I_WOUT };

struct Frame {
    unsigned char* lds;
    int tid, lane, wave, G, bid;
};

__device__ __forceinline__ float dpp_xor1(float v) { return __builtin_bit_cast(float, __builtin_amdgcn_update_dpp(0, __builtin_bit_cast(int, v), 0xB1, 0xF, 0xF, true)); }
__device__ __forceinline__ float dpp_xor2(float v) { return __builtin_bit_cast(float, __builtin_amdgcn_update_dpp(0, __builtin_bit_cast(int, v), 0x4E, 0xF, 0xF, true)); }
__device__ __forceinline__ float dpp_hmir(float v) { return __builtin_bit_cast(float, __builtin_amdgcn_update_dpp(0, __builtin_bit_cast(int, v), 0x141, 0xF, 0xF, true)); }
__device__ __forceinline__ float dpp_mir(float v)  { return __builtin_bit_cast(float, __builtin_amdgcn_update_dpp(0, __builtin_bit_cast(int, v), 0x140, 0xF, 0xF, true)); }
__device__ __forceinline__ float row16_sum(float v) { v += dpp_xor1(v); v += dpp_xor2(v); v += dpp_hmir(v); v += dpp_mir(v); return v; }

__device__ __forceinline__ float wave_sum(float v) {
    v = row16_sum(v);
    const float a = __builtin_bit_cast(float, __builtin_amdgcn_readlane(__builtin_bit_cast(int, v), 0)), b = __builtin_bit_cast(float, __builtin_amdgcn_readlane(__builtin_bit_cast(int, v), 16));
    const float c = __builtin_bit_cast(float, __builtin_amdgcn_readlane(__builtin_bit_cast(int, v), 32)), d = __builtin_bit_cast(float, __builtin_amdgcn_readlane(__builtin_bit_cast(int, v), 48));
    return (a + b) + (c + d);
}

__device__ __forceinline__ void transpose_item(const float* W, int K, int N, bf16* WT, int k0, int n0, int drow0, float* scr, int lane) {
    const int kr = lane >> 3, n4 = (lane & 7) * 4;
    f32x4 v[8];
#pragma unroll
    for (int i = 0; i < 8; ++i) v[i] = *(const f32x4*)(W + (size_t)(k0 + 8 * i + kr) * N + n0 + n4);
#pragma unroll
    for (int i = 0; i < 8; ++i) *(f32x4*)(scr + (8 * i + kr) * 32 + (n4 ^ (4 * i))) = v[i];
    LDS_WAIT(); asm volatile("" ::: "memory");
    const int c = lane & 7;
#pragma unroll
    for (int j = 0; j < 4; ++j) { const int n = (lane >> 3) + 8 * j; const float* s = scr + (8 * c) * 32 + (n ^ (4 * c));
        v4u o; o.x = pk2(s[0 * 32], s[1 * 32]); o.y = pk2(s[2 * 32], s[3 * 32]); o.z = pk2(s[4 * 32], s[5 * 32]); o.w = pk2(s[6 * 32], s[7 * 32]);
        *(v4u*)(WT + (size_t)(drow0 + n) * K + k0 + 8 * c) = o; }
    LDS_WAIT(); asm volatile("" ::: "memory");
}
__device__ __forceinline__ void convert_ffn(const Frame& F, const float* wi, const float* wo, unsigned char* wb, int wg_index, int wg_count) {
    float* scr = (float*)(F.lds + F.wave * 8448);
    const int gw = wg_index * NWAVES + F.wave, NGW = wg_count * NWAVES;
    constexpr int I_WI = (DM / 64) * (2 * DFF / 32), I_WO = (DFF / 64) * (DM / 32);
    bf16* WI = (bf16*)(wb + WB_WI); bf16* WO = (bf16*)(wb + WB_WO);
    for (int it = gw; it < I_WI + I_WO; it += NGW) {
        if (it < I_WI) { const int nblk = 2 * DFF / 32, kb = it / nblk, nb = it % nblk, n0 = nb * 32;
            const int j = n0 < DFF ? n0 : n0 - DFF, drow = 256 * (j >> 7) + (j & 127) + (n0 < DFF ? 0 : 128);
            transpose_item(wi, DM, 2 * DFF, WI, kb * 64, n0, drow, scr, F.lane); }
        else { const int r = it - I_WI, nblk = DM / 32, kb = r / nblk, nb = r % nblk;
            transpose_item(wo, DFF, DM, WO, kb * 64, nb * 32, nb * 32, scr, F.lane); }
    }
}
__device__ __forceinline__ void convert_mix(const Frame& F, const Args& A, int l, unsigned char* wb, const int late, const int widx, const int nwork) {
    float* scr = (float*)(F.lds + F.wave * 8448);
    const int gw = widx * NWAVES + F.wave, NGW = nwork * NWAVES;
    constexpr int NB_E = ZC_PAD / 32, NB_G = (INW - ZC_PAD) / 32, I_INE = (DM / 64) * NB_E, I_G = (DM / 64) * NB_G, I_UP = 4 * (512 / 64) * (DM / 32), I_OUT = (DM / 64) * (DM / 32);
    const float* w_in = A.in[I_WIN] + (size_t)l * DM * INW; const float* w_up = A.in[I_WUP] + (size_t)l * 4 * 512 * DM; const float* w_out = A.in[I_WOUT] + (size_t)l * DM * DM;
    bf16* WIN = (bf16*)(wb + WB_WIN); bf16* WG = (bf16*)(wb + WB_WG); bf16* WUP = (bf16*)(wb + WB_WUP); bf16* WOUT = (bf16*)(wb + WB_WOUT);
    if (late) {
        for (int it = gw; it < I_G + I_UP + I_OUT; it += NGW) {
            if (it < I_G) { const int kb = it / NB_G, nb = it % NB_G, n0 = ZC_PAD + nb * 32;
                transpose_item(w_in, DM, INW, WG, kb * 64, n0, n0 - ZC_PAD, scr, F.lane); }
            else if (it < I_G + I_UP) { const int r = it - I_G, per = (512 / 64) * (DM / 32), br = r / per, q = r % per, nblk = DM / 32, kb = q / nblk, nb = q % nblk;
                transpose_item(w_up + (size_t)br * 512 * DM, 512, DM, WUP + (size_t)br * DM * 512, kb * 64, nb * 32, nb * 32, scr, F.lane); }
            else { const int r = it - I_G - I_UP, nblk = DM / 32, kb = r / nblk, nb = r % nblk;
                transpose_item(w_out, DM, DM, WOUT, kb * 64, nb * 32, nb * 32, scr, F.lane); }
        }
        return;
    }
    for (int it = gw; it < I_INE; it += NGW) { const int kb = it / NB_E, nb = it % NB_E, n0 = nb * 32;
        transpose_item(w_in, DM, INW, WIN, kb * 64, n0, n0, scr, F.lane); }
    const int gt = F.bid * NTHR + F.tid, NGT = F.G * NTHR;
    { unsigned z_ = 0u; asm volatile("" : "+v"(z_));
      for (int i = gt; i < 128 * DM / 8; i += NGT) *(v4u*)(WIN + (size_t)ZC_PAD * DM + (size_t)i * 8) = (v4u){z_, z_, z_, z_}; }
    bf16* PW = (bf16*)(wb + WB_POOLW); bf16* W2T = (bf16*)(wb + WB_W2T); bf16* A2T = (bf16*)(wb + WB_A2T); bf16* G2T = (bf16*)(wb + WB_G2T);
    const float* pool_w = A.in[I_POOLW] + (size_t)l * 4 * 128 * 128; const float* w2 = A.in[I_W2] + (size_t)l * 2 * 96 * 512; const float* a2 = A.in[I_A2] + (size_t)l * 2 * 96 * 512; const float* g2 = A.in[I_G2] + (size_t)l * 256 * 512;
    for (int i = gt; i < 4 * 128 * 128; i += NGT) { const int g = i >> 14, d = (i >> 7) & 127, c = i & 127; PW[i] = (bf16)f2bf(pool_w[(g * 128 + c) * 128 + d]); }
    for (int i = gt; i < 2 * 512 * 96; i += NGT) { const int dd = i / (512 * 96), r = i % (512 * 96), n = r / 96, k = r % 96;
        W2T[i] = (bf16)f2bf(w2[(dd * 96 + k) * 512 + n]); A2T[i] = (bf16)f2bf(a2[(dd * 96 + k) * 512 + n]); }
    for (int i = gt; i < 512 * 256; i += NGT) { const int n = i >> 8, k = i & 255; G2T[i] = (bf16)f2bf(g2[k * 512 + n]); }
}

__device__ __forceinline__ void mod_partial(const Frame& F, const Args& A, float* modp) {
    float* sc = (float*)F.lds;
    for (int it = F.bid; it < 2 * 16 * 9; it += F.G) {
        const int l = it / 144, r = it % 144, ks = r / 9, nb = r % 9, k0 = ks * 128, n0 = nb * 2048 + F.tid * 4;
        __syncthreads();
        for (int i = F.tid; i < 9 * 128; i += NTHR) { const int bi = i >> 7, k = i & 127; const float cv = bi < 8 ? A.in[I_C][bi * DM + k0 + k] : A.in[I_CCTX][k0 + k]; sc[i] = cv * sigmoidf_(cv); }
        __syncthreads();
        const float* w = A.in[I_WMOD] + ((size_t)l * DM + k0) * NMOD + n0;
        f32x4 acc[9];
#pragma unroll
        for (int b = 0; b < 9; ++b) acc[b] = (f32x4){0.f, 0.f, 0.f, 0.f};
#pragma unroll 4
        for (int k = 0; k < 128; ++k) { const f32x4 wv = *(const f32x4*)(w + (size_t)k * NMOD);
#pragma unroll
            for (int b = 0; b < 9; ++b) acc[b] += wv * sc[b * 128 + k]; }
#pragma unroll
        for (int b = 0; b < 9; ++b) *(f32x4*)(modp + (((size_t)ks * 2 + l) * 9 + b) * NMOD + n0) = acc[b];
    }
    __syncthreads();
}
__device__ __forceinline__ void mod_reduce(const Frame& F, const Args& A, const float* modp, float* mod) {
    const int gt = F.bid * NTHR + F.tid, NGT = F.G * NTHR;
    for (int i = gt; i < 2 * 9 * NMOD / 4; i += NGT) { const int e = i * 4, l = e / (9 * NMOD), n = e % NMOD;
        f32x4 s = *(const f32x4*)(A.in[I_BMOD] + (size_t)l * NMOD + n);
#pragma unroll
        for (int ks = 0; ks < 16; ++ks) s += *(const f32x4*)(modp + (size_t)ks * 2 * 9 * NMOD + e);
        *(f32x4*)(mod + e) = s; }
}
__device__ __forceinline__ void rope_table(const Frame& F, float* tab, float* idln) {
    const int gt = F.bid * NTHR + F.tid;
    if (gt < 2 * DM) idln[gt] = gt < DM ? 1.0f : 0.0f;
    if (gt < 64 * 32) { const int p = gt >> 5, f = gt & 31; const float inv = powf(10000.0f, -(float)f / 32.0f); const float ang = (float)p * inv; tab[2 * gt] = cosf(ang); tab[2 * gt + 1] = sinf(ang); }
}

__device__ __forceinline__ const float* input_row(const Args& A, int row) { const int b = row / SA, s = row - b * SA; return s < CTXL ? A.in[I_CTX] + ((size_t)b * CTXL + s) * DM : A.in[I_X] + ((size_t)b * SEQ + (s - CTXL)) * DM; }
__device__ __forceinline__ void modulate_input(const Frame& F, const Args& A, const float* modl, bf16* H, _Float16* X, float* stats) {
    typedef _Float16 f16x8 __attribute__((ext_vector_type(8))); typedef float f32x8 __attribute__((ext_vector_type(8)));
    int NGW = F.G * NWAVES; asm volatile("" : "+s"(NGW));
    const int gw = F.bid * NWAVES + F.wave, per = (TOK + NGW - 1) / NGW;
    const int i0 = gw * per, i1 = (i0 + per) < TOK ? (i0 + per) : TOK;
    int cur_bi = -1; f32x8 Cv[4], Sv[4], nx[4];
#pragma unroll
    for (int j = 0; j < 4; ++j) { Cv[j] = (f32x8){0.f, 0.f, 0.f, 0.f, 0.f, 0.f, 0.f, 0.f}; Sv[j] = Cv[j]; nx[j] = Cv[j]; }
    if (i0 < i1) { const float* xr = input_row(A, i0);
#pragma unroll
        for (int j = 0; j < 4; ++j) nx[j] = *(const f32x8*)(xr + j * 512 + F.lane * 8); }
#pragma unroll 1
    for (int row = i0; row < i1; ++row) {
        const int b = row / SA, s = row - b * SA, bi = s < CTXL ? 8 : b;
        f32x8 a[4];
#pragma unroll
        for (int j = 0; j < 4; ++j) a[j] = nx[j];
        if (row + 1 < i1) { const float* xr = input_row(A, row + 1);
#pragma unroll
            for (int j = 0; j < 4; ++j) nx[j] = *(const f32x8*)(xr + j * 512 + F.lane * 8); }
        if (bi != cur_bi) { cur_bi = bi; const float* sh = modl + (size_t)bi * NMOD; const float* scl = sh + DM;
#pragma unroll
            for (int j = 0; j < 4; ++j) { const int c = j * 512 + F.lane * 8; Sv[j] = *(const f32x8*)(sh + c); Cv[j] = *(const f32x8*)(scl + c) + 1.0f; } }
        if (F.lane == 0) { stats[2 * (size_t)row] = 0.0f; stats[2 * (size_t)row + 1] = 1.0f; }
#pragma unroll
        for (int j = 0; j < 4; ++j) { const int c = j * 512 + F.lane * 8;
            const f32x8 h = a[j] * Cv[j] + Sv[j];
            v4u w; w.x = pk2(h[0], h[1]); w.y = pk2(h[2], h[3]); w.z = pk2(h[4], h[5]); w.w = pk2(h[6], h[7]);
            *(v4u*)(H + (size_t)row * DM + c) = w;
            *(f16x8*)(X + (size_t)row * DM + c) = __builtin_convertvector(a[j], f16x8); }
    }
}
__device__ __forceinline__ void ln_pass(const Frame& F, const _Float16* X, float* stats, const float* g, const float* bta, const float* modsh  , int kshift, bf16* H, float* out, bool latent_only, const int dry) {
    typedef _Float16 f16x8 __attribute__((ext_vector_type(8))); typedef float f32x8 __attribute__((ext_vector_type(8)));
    int NGW = F.G * NWAVES; asm volatile("" : "+s"(NGW));
    const int gw = F.bid * NWAVES + F.wave;
    const int nrows = latent_only ? NBATCH * SEQ : TOK, per = (nrows + NGW - 1) / NGW;
    int cur_bi = -1; f32x8 Gv[4], Bv[4];
#pragma unroll
    for (int j = 0; j < 4; ++j) { Gv[j] = (f32x8){0.f, 0.f, 0.f, 0.f, 0.f, 0.f, 0.f, 0.f}; Bv[j] = Gv[j]; }
    const int i0 = gw * per, i1 = (i0 + per) < nrows ? (i0 + per) : nrows;
    f16x8 raw[4];
    if (i0 < i1) { int r0 = i0; if (latent_only) { const int b0 = i0 / SEQ; r0 = b0 * SA + CTXL + (i0 - b0 * SEQ); }
#pragma unroll
        for (int j = 0; j < 4; ++j) raw[j] = *(const f16x8*)(X + (size_t)r0 * DM + j * 512 + F.lane * 8); }
#pragma unroll 1
    for (int idx = i0; idx < i1; ++idx) {
        int row, b, s;
        if (latent_only) { b = idx / SEQ; s = CTXL + (idx - b * SEQ); row = b * SA + s; } else { row = idx; b = row / SA; s = row - b * SA; }
        const int bi = s < CTXL ? 8 : b;
        f32x8 v[4]; float sum = 0.f;
#pragma unroll
        for (int j = 0; j < 4; ++j) { v[j] = __builtin_convertvector(raw[j], f32x8);
            sum += ((v[j][0] + v[j][1]) + (v[j][2] + v[j][3])) + ((v[j][4] + v[j][5]) + (v[j][6] + v[j][7])); }
        if (idx + 1 < i1) { int rn = idx + 1; if (latent_only) { const int bn = rn / SEQ; rn = bn * SA + CTXL + (rn - bn * SEQ); }
#pragma unroll
            for (int j = 0; j < 4; ++j) raw[j] = *(const f16x8*)(X + (size_t)rn * DM + j * 512 + F.lane * 8); }
        if (bi != cur_bi) { cur_bi = bi;
            const float* sh = modsh ? modsh + ((size_t)bi * 9 + kshift) * DM : nullptr;
#pragma unroll
            for (int j = 0; j < 4; ++j) { const int c = j * 512 + F.lane * 8;
#pragma unroll
                for (int q = 0; q < 2; ++q) { const f32x4 gg = *(const f32x4*)(g + c + 4 * q), bb = *(const f32x4*)(bta + c + 4 * q); f32x4 G_ = gg, B_ = bb;
                    if (sh) { const f32x4 sc = *(const f32x4*)(sh + DM + c + 4 * q) + 1.0f; G_ = gg * sc; B_ = bb * sc + *(const f32x4*)(sh + c + 4 * q); }
#pragma unroll
                    for (int e = 0; e < 4; ++e) { Gv[j][4 * q + e] = G_[e]; Bv[j][4 * q + e] = B_[e]; } } } }
        const float mean = wave_sum(sum) * (1.0f / DM); float s2 = 0.f;
#pragma unroll
        for (int j = 0; j < 4; ++j) { v[j] = v[j] - mean;
            s2 += ((v[j][0] * v[j][0] + v[j][1] * v[j][1]) + (v[j][2] * v[j][2] + v[j][3] * v[j][3])) + ((v[j][4] * v[j][4] + v[j][5] * v[j][5]) + (v[j][6] * v[j][6] + v[j][7] * v[j][7])); }
        const float rstd = 1.0f / sqrtf(wave_sum(s2) * (1.0f / DM) + LN_EPS);
        if (!dry && F.lane == 0) { stats[2 * (size_t)row] = mean; stats[2 * (size_t)row + 1] = rstd; }
#pragma unroll
        for (int j = 0; j < 4; ++j) { const int c = j * 512 + F.lane * 8;
            const f32x8 y = v[j] * rstd * Gv[j] + Bv[j];
            if (out) { const f32x4 y0 = (f32x4){y[0], y[1], y[2], y[3]}, y1 = (f32x4){y[4], y[5], y[6], y[7]};
                if (dry) asm volatile("" :: "v"(y0), "v"(y1)); else if (s >= CTXL) { float* o = out + ((size_t)b * SEQ + (s - CTXL)) * DM + c; *(f32x4*)o = y0; *(f32x4*)(o + 4) = y1; } }
            if (H) { v4u w; w.x = pk2(y[0], y[1]); w.y = pk2(y[2], y[3]); w.z = pk2(y[4], y[5]); w.w = pk2(y[6], y[7]); if (!dry) *(v4u*)(H + (size_t)row * DM + c) = w; else asm volatile("" :: "v"(w)); } }
    }
}

__device__ __forceinline__ v4u ldz8(const bf16* p) { return *(const v4u*)p; }
__device__ __forceinline__ float group8_sum(float v) { v += dpp_xor1(v); v += dpp_xor2(v); v += dpp_hmir(v); return v; }
__device__ __forceinline__ int crow_(int r, int hi) { return (r & 3) + 8 * (r >> 2) + 4 * hi; }

struct MixPtrs {
    bf16* Z; bf16* POOL; bf16* O0; bf16* O1; bf16* RWR; bf16* RWK; bf16* RWV; bf16* RWKK; bf16* RWA0; bf16* RWA1; bf16* RWG; float* RWW0; float* RWW1;
    float* BON;
};

template <int TT> __device__ __forceinline__ void prep_tile(const Frame& F, const Args& A, int l, const MixPtrs& P, const unsigned char* wb, const float* ropetab, int ti, const int dry, const int parts) {
    constexpr int TPB = SA / TT, TCX = CTXL / TT;
    const int b = ti / TPB, tl = ti - b * TPB; const bool isctx = tl < TCX;
    const int t0 = isctx ? tl * TT : (tl - TCX) * TT, T = isctx ? CTXL : SEQ, segrow0 = b * SA + (isctx ? 0 : CTXL);
    const int r32 = F.lane & 31, hi = F.lane >> 5;
    unsigned char* lds = F.lds;
    constexpr int LWS = 400, LGS = 528, LW_OFF = 0, LA_OFF = TT * LWS, LG_OFF = 2 * TT * LWS;
#ifndef PREP_REP_A
#define PREP_REP_A 1
#endif
    if constexpr (TT == 64) if (parts & 1) for (int prp_ = 0; prp_ < PREP_REP_A; ++prp_) { const int pdry = dry | (prp_ + 1 < PREP_REP_A ? 1 : 0); (void)pdry;
    constexpr int PLS = 1040;
#pragma unroll 1
    for (int k = 0; k < 8; ++k) {
        const int tt = F.wave + 8 * k, ch8 = F.lane, g = ch8 >> 4, half = 1 << g, t = t0 + tt;
        const int lo = (t - half) > 0 ? (t - half) : 0, hi_ = (t + half) < T ? (t + half) : T;
        float acc[8] = {0.f, 0.f, 0.f, 0.f, 0.f, 0.f, 0.f, 0.f};
        const bf16* zc = P.Z + (size_t)segrow0 * NZ + ZC_POOL + ch8 * 8;
        v4u wv[16];
#pragma unroll
        for (int i = 0; i < 16; ++i) { const int tau = t - half + i; const bool ok = (i < 2 * half) && tau >= 0 && tau < T; wv[i] = ok ? ldz8(zc + (size_t)tau * NZ) : (v4u){0u, 0u, 0u, 0u}; }
#pragma unroll
        for (int i = 0; i < 16; ++i) { float f[8]; unpack8(wv[i], f);
#pragma unroll
            for (int j = 0; j < 8; ++j) acc[j] += f[j]; }
        float own[8]; unpack8(ldz8(zc + (size_t)t * NZ), own);
        const float inv = 1.0f / (float)(hi_ - lo);
        float o[8];
#pragma unroll
        for (int j = 0; j < 8; ++j) o[j] = acc[j] * inv - own[j];
        *(v4u*)(lds + tt * PLS + ch8 * 16) = pack8(o);
    }
    __syncthreads();
    {
        const int g = F.wave & 3, mh = F.wave >> 2;
        const bf16* PW = (const bf16*)(wb + WB_POOLW);
        const float* ps = A.in[I_POOLS] + l * 512;
#pragma unroll 1
        for (int nt = 0; nt < 4; ++nt) {
            const int col = g * 128 + nt * 32 + r32;
            const bf16* bt = PW + (size_t)col * 128 + hi * 8; const unsigned char* ap = lds + (mh * 32 + r32) * PLS + (g * 128 + hi * 8) * 2;
            f32x16 acc = {};
            bf16x8 b_[8];
#pragma unroll
            for (int ks = 0; ks < 8; ++ks) b_[ks] = *(const bf16x8*)(bt + ks * 16);
#pragma unroll
            for (int ks = 0; ks < 8; ++ks) { const bf16x8 a_ = *(const bf16x8*)(ap + ks * 32); acc = __builtin_amdgcn_mfma_f32_32x32x16_bf16(a_, b_[ks], acc, 0, 0, 0); }
            const float sc = ps[col]; bf16* OP = P.POOL + (size_t)(segrow0 + t0 + mh * 32 + 4 * hi) * 512 + col;
#pragma unroll
            for (int r = 0; r < 16; ++r) OP[((r & 3) + 8 * (r >> 2)) * 512] = (bf16)f2bf(acc[r] * sc);
        }
    }
    __syncthreads();
    }
#ifndef PREP_REP_B
#define PREP_REP_B 1
#endif
    if (parts & 2) for (int prp_ = 0; prp_ < PREP_REP_B; ++prp_) { const int pdry = dry | (prp_ + 1 < PREP_REP_B ? 1 : 0); (void)pdry;
    {
        const float* mu = A.in[I_MU] + l * 2176; const float* kkw = A.in[I_KK] + l * 512;
#define PREP_EMIT(tt_, c_, zs_) do { const size_t row = (size_t)(segrow0 + t0 + (tt_)); \
            if ((c_) < 512) *(v4u*)(P.RWR + row * 512 + (c_)) = pack8(zs_); \
            else if ((c_) < 1024) { float kkv[8]; float ss = 0.f; _Pragma("unroll") for (int e = 0; e < 8; ++e) { kkv[e] = zs_[e] * kw[e]; ss += kkv[e] * kkv[e]; } \
                ss = group8_sum(ss); *(v4u*)(P.RWK + row * 512 + (c_) - 512) = pack8(zs_); const float rn = 1.0f / sqrtf(ss + 1e-12f); \
                _Pragma("unroll") for (int e = 0; e < 8; ++e) kkv[e] *= rn; \
                *(v4u*)(P.RWKK + row * 512 + (c_) - 512) = pack8(kkv); } \
            else if ((c_) < 1536) *(v4u*)(P.RWV + row * 512 + (c_) - 1024) = pack8(zs_); \
            else if ((c_) < 1728) { float o[8]; _Pragma("unroll") for (int e = 0; e < 8; ++e) o[e] = 1.0f - 2.0f * __builtin_amdgcn_rcpf(1.0f + __expf(2.0f * zs_[e])); \
                *(v4u*)(lds + LW_OFF + (tt_) * LWS + ((c_) - 1536) * 2) = pack8(o); } \
            else if ((c_) < 1920) *(v4u*)(lds + LA_OFF + (tt_) * LWS + ((c_) - 1728) * 2) = pack8(zs_); \
            else { float o[8]; _Pragma("unroll") for (int e = 0; e < 8; ++e) o[e] = sigmoidf_(zs_[e]); \
                *(v4u*)(lds + LG_OFF + (tt_) * LGS + ((c_) - 1920) * 2) = pack8(o); } } while (0)
        {
            constexpr int HT = TT / 2;
            const int cg = F.tid & 255, tb = (F.tid >> 8) * HT, c = cg * 8, tg = t0 + tb;
            float m8[8], kw[8];
            { const f32x4 m0 = *(const f32x4*)(mu + c), m1 = *(const f32x4*)(mu + c + 4);
#pragma unroll
              for (int e = 0; e < 8; ++e) { m8[e] = e < 4 ? m0[e] : m1[e - 4]; kw[e] = 0.f; } }
            if (c >= 512 && c < 1024) { const f32x4 k0 = *(const f32x4*)(kkw + c - 512), k1 = *(const f32x4*)(kkw + c - 512 + 4);
#pragma unroll
                for (int e = 0; e < 8; ++e) kw[e] = e < 4 ? k0[e] : k1[e - 4]; }
            const bf16* zp = P.Z + (size_t)(segrow0 + tg) * NZ + ZC_RWKV + c;
            float prv[8], cur[8];
            if (tg > 0) unpack8(ldz8(zp - NZ), prv); else {
#pragma unroll
                for (int e = 0; e < 8; ++e) prv[e] = 0.f; }
            unpack8(ldz8(zp), cur);
#pragma unroll 1
            for (int i = 0; i < HT; i += 4) {
                v4u raw[4];
#pragma unroll
                for (int j = 0; j < 4; ++j) { const bool ok = (tg + i + j + 1) < T; raw[j] = ok ? ldz8(zp + (size_t)(i + j + 1) * NZ) : (v4u){0u, 0u, 0u, 0u}; }
#pragma unroll
                for (int j = 0; j < 4; ++j) { float nxt[8], zs[8]; unpack8(raw[j], nxt);
#pragma unroll
                    for (int e = 0; e < 8; ++e) zs[e] = cur[e] + (0.5f * (prv[e] + nxt[e]) - cur[e]) * m8[e];
                    PREP_EMIT(tb + i + j, c, zs);
#pragma unroll
                    for (int e = 0; e < 8; ++e) { prv[e] = cur[e]; cur[e] = nxt[e]; } }
            }
        }
#pragma unroll 1
        for (int it = F.tid; it < TT * 16; it += NTHR) {
            const int tt = it >> 4, c = 2048 + (it & 15) * 8, t = t0 + tt;
            const bf16* zp = P.Z + (size_t)(segrow0 + t) * NZ + ZC_RWKV + c;
            float cur[8], prv[8], nxt[8], kw[8];
            unpack8(ldz8(zp), cur);
            if (t > 0) unpack8(ldz8(zp - NZ), prv); else {
#pragma unroll
                for (int e = 0; e < 8; ++e) prv[e] = 0.f; }
            if (t < T - 1) unpack8(ldz8(zp + NZ), nxt); else {
#pragma unroll
                for (int e = 0; e < 8; ++e) nxt[e] = 0.f; }
            const f32x4 m0 = *(const f32x4*)(mu + c), m1 = *(const f32x4*)(mu + c + 4);
            float zs[8];
#pragma unroll
            for (int e = 0; e < 8; ++e) { const float m = e < 4 ? m0[e] : m1[e - 4]; zs[e] = cur[e] + (0.5f * (prv[e] + nxt[e]) - cur[e]) * m; kw[e] = 0.f; }
            PREP_EMIT(tt, c, zs);
        }
#undef PREP_EMIT
    }
    __syncthreads();
    }
#ifndef PREP_REP_M
#define PREP_REP_M 1
#endif
    if (parts & 2) for (int prp_ = 0; prp_ < PREP_REP_M; ++prp_) { const int pdry = dry | (prp_ + 1 < PREP_REP_M ? 1 : 0); (void)pdry;
    {
        const bf16* W2T = (const bf16*)(wb + WB_W2T); const bf16* A2T = (const bf16*)(wb + WB_A2T); const bf16* G2T = (const bf16*)(wb + WB_G2T);
#pragma unroll 1
        for (int q = 0; q < 5 * (TT / 32); ++q) {
            const int job = q / (TT / 32), mt = (TT == 64) ? (q & 1) : 0, d = job & 1;
            const int col = F.wave * 64 + r32;
            const int loff = job < 2 ? LW_OFF : job < 4 ? LA_OFF : LG_OFF, lstr = job < 4 ? LWS : LGS, koff = job < 4 ? d * 96 : 0, kfull = job < 4 ? 96 : 256;
            const bf16* bt = (job < 2 ? W2T + (size_t)d * 512 * 96 : job < 4 ? A2T + (size_t)d * 512 * 96 : G2T) + (size_t)col * kfull + hi * 8;
            const unsigned char* ap = lds + loff + (mt * 32 + r32) * lstr + (koff + hi * 8) * 2;
            f32x16 acc0 = {}, acc1 = {};
            if (job < 4) { bf16x8 b0_[6], b1_[6];
#pragma unroll
                for (int ks = 0; ks < 6; ++ks) { b0_[ks] = *(const bf16x8*)(bt + ks * 16); b1_[ks] = *(const bf16x8*)(bt + 32 * 96 + ks * 16); }
#pragma unroll
                for (int ks = 0; ks < 6; ++ks) { const bf16x8 a_ = *(const bf16x8*)(ap + ks * 32); acc0 = __builtin_amdgcn_mfma_f32_32x32x16_bf16(a_, b0_[ks], acc0, 0, 0, 0); acc1 = __builtin_amdgcn_mfma_f32_32x32x16_bf16(a_, b1_[ks], acc1, 0, 0, 0); } }
            else { bf16x8 b0_[16], b1_[16];
#pragma unroll
                for (int ks = 0; ks < 16; ++ks) { b0_[ks] = *(const bf16x8*)(bt + ks * 16); b1_[ks] = *(const bf16x8*)(bt + 32 * 256 + ks * 16); }
#pragma unroll
                for (int ks = 0; ks < 16; ++ks) { const bf16x8 a_ = *(const bf16x8*)(ap + ks * 32); acc0 = __builtin_amdgcn_mfma_f32_32x32x16_bf16(a_, b0_[ks], acc0, 0, 0, 0); acc1 = __builtin_amdgcn_mfma_f32_32x32x16_bf16(a_, b1_[ks], acc1, 0, 0, 0); } }
            const size_t rowb = (size_t)(segrow0 + t0 + mt * 32 + 4 * hi) * 512 + col;
            if (job < 2) { float* WP = (d ? P.RWW1 : P.RWW0) + rowb; const float* w0 = A.in[I_W0] + (l * 2 + d) * 512 + col; const float w0a = w0[0], w0b = w0[32];
#pragma unroll
                for (int r = 0; r < 16; ++r) { const int ro = ((r & 3) + 8 * (r >> 2)) * 512; WP[ro] = __expf(-0.6065306597126334f * sigmoidf_(acc0[r] + w0a)); WP[ro + 32] = __expf(-0.6065306597126334f * sigmoidf_(acc1[r] + w0b)); } }
            else if (job < 4) { bf16* AP = (d ? P.RWA1 : P.RWA0) + rowb; const float* a0 = A.in[I_A0] + (l * 2 + d) * 512 + col; const float a0a = a0[0], a0b = a0[32];
#pragma unroll
                for (int r = 0; r < 16; ++r) { const int ro = ((r & 3) + 8 * (r >> 2)) * 512; AP[ro] = (bf16)f2bf(sigmoidf_(acc0[r] + a0a)); AP[ro + 32] = (bf16)f2bf(sigmoidf_(acc1[r] + a0b)); } }
            else { bf16* GP = P.RWG + rowb;
#pragma unroll
                for (int r = 0; r < 16; ++r) { const int ro = ((r & 3) + 8 * (r >> 2)) * 512; GP[ro] = (bf16)f2bf(acc0[r]); GP[ro + 32] = (bf16)f2bf(acc1[r]); } }
        }
    }
    }
#ifndef PREP_REP_C
#define PREP_REP_C 1
#endif
    if (parts & 2) for (int prp_ = 0; prp_ < PREP_REP_C; ++prp_) { const int pdry = dry | (prp_ + 1 < PREP_REP_C ? 1 : 0); (void)pdry;
    {
        const float* qn = A.in[I_QN] + l * 128; const float* kn = A.in[I_KN] + l * 128;
#pragma unroll 3
        for (int it = F.tid; it < TT * 96; it += NTHR) {
            const int sub = it & 7, hd = (it >> 3) % 12, tt = it / 96, a = sub >> 2, fc = sub & 3, t = t0 + tt;
            const bool dense = hd >= 6;
            bf16* p = P.Z + (size_t)(segrow0 + t) * NZ + (dense ? ZC_DENSE + (hd - 6) * 128 : ZC_WIN + hd * 128) + a * 64 + fc * 8;
            float x1[8], x2[8]; unpack8(ldz8(p), x1); unpack8(ldz8(p + 32), x2);
            float ss = 0.f;
            if (dense) {
#pragma unroll
                for (int j = 0; j < 8; ++j) ss += x1[j] * x1[j] + x2[j] * x2[j]; }
            ss = group8_sum(ss);
            if (dense) { const float rinv = 1.0f / sqrtf(ss * (1.0f / 128.0f) + RMS_EPS); const float* gn = (hd < 10 ? qn : kn) + a * 64 + fc * 8;
#pragma unroll
                for (int j = 0; j < 8; ++j) { x1[j] *= rinv * gn[j]; x2[j] *= rinv * gn[32 + j]; } }
            if (!isctx) { const int pos = a == 0 ? (t >> 6) : (t & 63); const float* cs = ropetab + (pos * 32 + fc * 8) * 2;
#pragma unroll
                for (int j = 0; j < 8; ++j) { const float c_ = cs[2 * j], s_ = cs[2 * j + 1]; const float y1 = x1[j] * c_ - x2[j] * s_, y2 = x2[j] * c_ + x1[j] * s_; x1[j] = y1; x2[j] = y2; } }
            if ((dense || !isctx) && !pdry) { *(v4u*)p = pack8(x1); *(v4u*)(p + 32) = pack8(x2); }
        }
    }
    }
    __syncthreads();
}

__device__ __forceinline__ void scan_unit(const Frame& F, const Args& A, int l, const MixPtrs& P, int u) {
    const int h = u & 7, b = (u >> 3) & 7, d = u >> 6;
    constexpr int STEP_F = 384, CH = 32, BUF_F = CH * STEP_F;
    float* lbuf = (float*)F.lds; float* part = lbuf + 2 * BUF_F + F.wave * 1024;
    const int ls = F.tid >> 4, j4 = (F.tid & 15) * 4, col = h * 64 + j4;
    const bf16* pa = d ? P.RWA1 : P.RWA0; const float* pw = d ? P.RWW1 : P.RWW0; bf16* po = d ? P.O1 : P.O0;
    const f32x4 ka4 = *(const f32x4*)(A.in[I_KA] + l * 512 + col);
    const size_t brow = (size_t)b * SA;
    struct { v2u r, k, v, kk, a; f32x4 w; } st;
#define SROW(n) (brow + (size_t)(d == 0 ? (n) : ((n) < CTXL ? (CTXL - 1 - (n)) : (SA + CTXL - 1 - (n)))))
#define SC_LOAD(c) do { const size_t o_ = SROW((c) * CH + ls) * 512 + col; st.r = *(const v2u*)(P.RWR + o_); st.k = *(const v2u*)(P.RWK + o_); st.v = *(const v2u*)(P.RWV + o_); \
        st.kk = *(const v2u*)(P.RWKK + o_); st.a = *(const v2u*)(pa + o_); st.w = *(const f32x4*)(pw + o_); } while (0)
#define SC_WRITE(bufi, chunk) do { float* q_ = lbuf + (bufi) * BUF_F + ls * STEP_F; \
        const f32x4 kk_ = (f32x4){bflo(st.kk.x), bfhi(st.kk.x), bflo(st.kk.y), bfhi(st.kk.y)}, a_ = (f32x4){bflo(st.a.x), bfhi(st.a.x), bflo(st.a.y), bfhi(st.a.y)}; \
        const f32x4 k_ = (f32x4){bflo(st.k.x), bfhi(st.k.x), bflo(st.k.y), bfhi(st.k.y)}, r_ = (f32x4){bflo(st.r.x), bfhi(st.r.x), bflo(st.r.y), bfhi(st.r.y)}; \
        const f32x4 krep_ = k_ * ((a_ - 1.0f) * ka4 + 1.0f); \
        *(f32x4*)(q_ + j4) = kk_; *(f32x4*)(q_ + 64 + j4) = st.w; *(f32x4*)(q_ + 128 + j4) = kk_ * a_; *(f32x4*)(q_ + 192 + j4) = krep_; *(f32x4*)(q_ + 256 + j4) = r_; \
        *(f32x4*)(q_ + 320 + j4) = (f32x4){bflo(st.v.x), bfhi(st.v.x), bflo(st.v.y), bfhi(st.v.y)}; (void)(chunk); } while (0)
    typedef float f32x2 __attribute__((ext_vector_type(2)));
    const int r0 = F.wave * 8 + (F.lane >> 4) * 2, jg = F.lane & 15;
    float* pwa = part + ((F.lane >> 4) * 2) * 16 + jg;
    const float* prd = part + F.lane * 16; const int psl = F.lane >> 3, prow = F.wave * 8 + (F.lane & 7);
    const int prot = (F.lane >> 2) & 3, pr0 = 4 * prot, pr1 = 4 * ((prot + 1) & 3), pr2 = 4 * ((prot + 2) & 3), pr3 = 4 * ((prot + 3) & 3);
    f32x2 Sa0 = (f32x2){0.f, 0.f}, Sa1 = Sa0, Sb0 = Sa0, Sb1 = Sa0;
    __syncthreads();
    SC_LOAD(0); SC_WRITE(0, 0);
    __syncthreads();
    constexpr int NCH = SA / CH;
#pragma unroll 1
    for (int c = 0; c < NCH; ++c) {
        if (c + 1 < NCH) SC_LOAD(c + 1);
        const float* cb = lbuf + (c & 1) * BUF_F;
        const float* q0_ = cb + jg * 4; const float* v0_ = cb + 320 + r0;
#define SC_LD(KK, W, BB, KR, RR, VV, st_) do { const float* q_ = q0_ + (st_) * STEP_F; KK = *(const f32x4*)(q_); W = *(const f32x4*)(q_ + 64); BB = *(const f32x4*)(q_ + 128); KR = *(const f32x4*)(q_ + 192); RR = *(const f32x4*)(q_ + 256); VV = *(const f32x2*)(v0_ + (st_) * STEP_F); } while (0)
        f32x4 akk, aw, abb, akr, arr, bkk, bw, bbb, bkr, brr; f32x2 avv, bvv;
        SC_LD(akk, aw, abb, akr, arr, avv, 0); SC_LD(bkk, bw, bbb, bkr, brr, bvv, 1);
#pragma unroll
        for (int s = 0; s < CH; ++s) {
            const f32x4 kk = akk, w = aw, bb = abb, kr = akr, rr = arr; const f32x2 vv = avv;
            akk = bkk; aw = bw; abb = bbb; akr = bkr; arr = brr; avv = bvv;
            if (s + 2 < CH) SC_LD(bkk, bw, bbb, bkr, brr, bvv, s + 2);
            __builtin_amdgcn_sched_barrier(0);
#define LO2(x) __builtin_shufflevector(x, x, 0, 1)
#define HI2(x) __builtin_shufflevector(x, x, 2, 3)
            const f32x2 kk0 = LO2(kk), kk1 = HI2(kk), w0 = LO2(w), w1 = HI2(w), bb0 = LO2(bb), bb1 = HI2(bb), kr0 = LO2(kr), kr1 = HI2(kr), rr0 = LO2(rr), rr1 = HI2(rr);
            const f32x2 ta = Sa1 * kk1 + Sa0 * kk0, tb = Sb1 * kk1 + Sb0 * kk0;
            float ska = ta.x + ta.y, skb = tb.x + tb.y;
            ska += dpp_xor1(ska); skb += dpp_xor1(skb); ska += dpp_xor2(ska); skb += dpp_xor2(skb); ska += dpp_hmir(ska); skb += dpp_hmir(skb); ska += dpp_mir(ska); skb += dpp_mir(skb);
            const f32x2 pa0 = Sa0 * w0 + kr0 * vv.x, pa1 = Sa1 * w1 + kr1 * vv.x, pb0 = Sb0 * w0 + kr0 * vv.y, pb1 = Sb1 * w1 + kr1 * vv.y;
            Sa0 = pa0 - bb0 * ska; Sa1 = pa1 - bb1 * ska;
            Sb0 = pb0 - bb0 * skb; Sb1 = pb1 - bb1 * skb;
            const f32x2 ua = Sa1 * rr1 + Sa0 * rr0, ub = Sb1 * rr1 + Sb0 * rr0;
            pwa[(s & 7) * 128] = ua.x + ua.y; pwa[(s & 7) * 128 + 16] = ub.x + ub.y;
#undef LO2
#undef HI2
            if ((s & 7) == 7) {
                const f32x4 p0 = *(const f32x4*)(prd + pr0), p1 = *(const f32x4*)(prd + pr1), p2 = *(const f32x4*)(prd + pr2), p3 = *(const f32x4*)(prd + pr3);
                const f32x4 q = (p0 + p1) + (p2 + p3); const float ov = (q[0] + q[1]) + (q[2] + q[3]);
                po[SROW(c * CH + (s - 7) + psl) * 512 + h * 64 + prow] = (bf16)f2bf(ov);
            }
        }
#undef SC_LD
        if (c + 1 < NCH) SC_WRITE((c + 1) & 1, c + 1);
        __syncthreads();
    }
#undef SROW
#undef SC_LOAD
#undef SC_WRITE
}

__device__ __forceinline__ void rwkv_out(const Frame& F, const Args& A, int l, const MixPtrs& P, bool latent_only, const int dry) {
    typedef float f32x2 __attribute__((ext_vector_type(2)));
    const int gw = F.bid * NWAVES + F.wave, NGW = F.G * NWAVES, c = F.lane * 8, hh = F.lane >> 3;
    const float* gng = A.in[I_GNG] + l * 512 + c; const float* gnb = A.in[I_GNB] + l * 512 + c;
    const float* ka = A.in[I_KA] + l * 512 + c; const float* rk = A.in[I_RK] + l * 512 + c;
    float g8[8], b8[8], ka8[8], rk8[8];
#pragma unroll
    for (int j = 0; j < 8; ++j) { g8[j] = gng[j]; b8[j] = gnb[j]; ka8[j] = ka[j]; rk8[j] = rk[j]; }
    const int nrows = latent_only ? NBATCH * SEQ : TOK;
#pragma unroll 2
    for (int idx = gw; idx < nrows; idx += NGW) {
        const int row = latent_only ? (idx >> 12) * SA + CTXL + (idx & (SEQ - 1)) : idx;
        const size_t o = (size_t)row * 512 + c;
        float o0[8], o1[8], v[8], gg[8], r[8], k[8], a0[8], a1[8];
        unpack8(ldz8(P.O0 + o), o0); unpack8(ldz8(P.O1 + o), o1); unpack8(ldz8(P.RWV + o), v); unpack8(ldz8(P.RWG + o), gg);
        unpack8(ldz8(P.RWR + o), r); unpack8(ldz8(P.RWK + o), k); unpack8(ldz8(P.RWA0 + o), a0); unpack8(ldz8(P.RWA1 + o), a1);
        float bp = 0.f;
#pragma unroll
        for (int j = 0; j < 8; ++j) bp += r[j] * rk8[j] * k[j] * (2.0f + (a0[j] + a1[j] - 2.0f) * ka8[j]);
        const float bonus = group8_sum(bp);
        float sm = 0.f;
#pragma unroll
        for (int j = 0; j < 8; ++j) { o0[j] += o1[j]; sm += o0[j]; }
        const float mu = group8_sum(sm) * (1.0f / 64.0f);
        float vs = 0.f;
#pragma unroll
        for (int j = 0; j < 8; ++j) { o0[j] -= mu; vs += o0[j] * o0[j]; }
        const float rstd = 1.0f / sqrtf(group8_sum(vs) * (1.0f / 64.0f) + GN_EPS);
        float out[8];
#pragma unroll
        for (int j = 0; j < 8; ++j) out[j] = (o0[j] * rstd * g8[j] + b8[j] + bonus * v[j]) * gg[j];
        if (!dry) *(v4u*)(P.RWR + o) = pack8(out); else asm volatile("" :: "v"(out[0]), "v"(out[7]));
    }
}

__device__ __forceinline__ void attention_unit(const Frame& F, const Args& A, int l, bf16* Z, int u, const int dry) {
    char* lds = (char*)F.lds;
    const bool isctx = u >= 1024;
    const bool win = isctx ? (u >= 1056) : (u >= 512);
    int b, h, qrow, NT = 4, bs = 0, q0 = 0;
    if (!isctx) { const int v = u & 511, qb = v & 15; h = (v >> 4) & 3; b = v >> 6; q0 = qb * 256; qrow = CTXL + q0; NT = SA / 64; }
    else { const int v = (u - 1024) & 31; h = v & 3; b = v >> 2; qrow = 0; }
    const int kvh = h >> 1, zc = win ? ZC_WIN : ZC_DENSE;
    bf16* zb = Z + (size_t)b * SA * NZ;
    bf16* Q = zb + (size_t)qrow * NZ + zc + h * 128;
    const bf16* K = zb + zc + 512 + kvh * 128; const bf16* V = zb + zc + 768 + kvh * 128;
    float m0 = -1e30f, l0 = 0.f;
    if (win) { m0 = A.in[I_SINK][l * 4 + h] / att::SCALE; l0 = 1.0f; }
    const bool band = win && !isctx;
    if (band) { bs = q0 >= 128 ? q0 - 128 : 0; const int be = (q0 + 384) < SEQ ? (q0 + 384) : SEQ; NT = 4 + (be - bs) / 64; }
    att::attn_body(band, Q, K, V, Q, NT, bs, q0, m0, l0, lds, dry);
}

#ifndef REP_MOD
#define REP_MOD 1
#endif
#ifndef REP_WI
#define REP_WI 1
#endif
#ifndef REP_WO
#define REP_WO 1
#endif
#ifndef REP_LN
#define REP_LN 1
#endif
#ifndef REP_WIN
#define REP_WIN 1
#endif
#ifndef REP_PREP
#define REP_PREP 1
#endif
#ifndef REP_ATT
#define REP_ATT 1
#endif
#ifndef REP_SCAN
#define REP_SCAN 1
#endif
#ifndef REP_RWO
#define REP_RWO 1
#endif
#ifndef REP_U
#define REP_U 1
#endif
#ifndef REP_G
#define REP_G 1
#endif
#ifndef REP_WOUT
#define REP_WOUT 1
#endif
#define REPEAT(N) for (int rep_ = 0; rep_ < (N); ++rep_) { const int dry = (rep_ + 1 < (N)) ? 1 : 0; (void)dry; if (rep_) __syncthreads();
#define REPEAT_END }

#define PH_BEGIN { GAS unsigned char* wsg_ = (GAS unsigned char*)args.ws; asm volatile("" : "+s"(wsg_)); unsigned char* ws = (unsigned char*)wsg_;     \
    int tid_ = threadIdx.x; asm volatile("" : "+v"(tid_)); \
    Frame F; F.lds = lds; F.tid = tid_; F.lane = tid_ & 63; F.wave = __builtin_amdgcn_readfirstlane(tid_ >> 6); { int g_ = gridDim.x; asm volatile("" : "+s"(g_)); F.G = g_; } F.bid = blockIdx.x; \
    PG8_LAS unsigned char* ldsl = (PG8_LAS unsigned char*)lds; unsigned char* R = ws + WS_R; unsigned char* WB = ws + WS_WB; float* MOD = (float*)(ws + WS_MOD); _Float16* X = (_Float16*)(ws + WS_X); bf16* H = (bf16*)(ws + WS_H); float* STATS = (float*)(ws + WS_STATS); (void)STATS; \
    const float* modl = MOD + (size_t)l * 9 * NMOD; (void)ldsl; (void)R; (void)WB; (void)X; (void)H; (void)modl; (void)F;
#define GRID_BARRIER() do { GAS unsigned char* wsbg_ = (GAS unsigned char*)args.ws; asm volatile("" : "+s"(wsbg_)); unsigned char* wsb_ = (unsigned char*)wsbg_; XcdBarrier b_; b_.bar = (unsigned*)(wsb_ + WS_CTL); b_.x = xb_xcc_id(); b_.st = (volatile LAS unsigned*)((PG8_LAS unsigned char*)lds + MISC_OFF + 32); xcd_barrier(b_); } while (0)
#define PH_END } GRID_BARRIER();
#define MIXPTRS() MixPtrs P; P.Z = (bf16*)(R + R_Z); P.POOL = (bf16*)(R + R_POOL); P.O0 = (bf16*)(R + R_O0); P.O1 = (bf16*)(R + R_O1); P.RWR = (bf16*)(R + R_RWR); P.RWK = (bf16*)(R + R_RWK); P.RWV = (bf16*)(R + R_RWV); \
    P.RWKK = (bf16*)(R + R_RWKK); P.RWA0 = (bf16*)(R + R_RWA0); P.RWA1 = (bf16*)(R + R_RWA1); P.RWG = (bf16*)(R + R_RWG); P.RWW0 = (float*)(R + R_RWW0); P.RWW1 = (float*)(R + R_RWW1); P.BON = (float*)(ws + WS_BON);

__global__ void __launch_bounds__(NTHR, 2) fwd_kernel(Args args) {
    extern __shared__ __attribute__((aligned(16))) unsigned char lds[];
    {
        PG8_LAS unsigned char* ldsl0 = (PG8_LAS unsigned char*)lds;
        for (int u = threadIdx.x; u < (LDS_BYTES - LDSCTL_OFF) / 4; u += NTHR) ((LAS unsigned*)(ldsl0 + LDSCTL_OFF))[u] = 0u;
    }
    __syncthreads();
    (void)xcd_barrier_post((unsigned*)(args.ws + WS_CTL), (volatile LAS unsigned*)((PG8_LAS unsigned char*)lds + MISC_OFF + 32));

    { const int l = 0;
      PH_BEGIN REPEAT(REP_MOD) mod_partial(F, args, (float*)(R + R_MODP)); rope_table(F, (float*)(ws + WS_ROPE), (float*)(ws + WS_IDLN)); convert_ffn(F, args.in[I_F1WI], args.in[I_F1WO], WB, F.bid, F.G); REPEAT_END PH_END
      PH_BEGIN mod_reduce(F, args, (const float*)(R + R_MODP), MOD); PH_END
      PH_BEGIN modulate_input(F, args, MOD, H, X, STATS); PH_END }

#pragma unroll 1
    for (int l = 0; l < 2; ++l) {
        const bool last = (l == 1);
#pragma unroll 1
        for (int f = 0; f < 2; ++f) {
            const int mode = (last && f == 1) ? 1 : 0, nM = mode ? 128 : NPAN;
            PH_BEGIN
              const unsigned char* wbf = ws + ((f == 0) ? ((l == 1 && F.G >= 256) ? WS_WB4 : WS_WB) : WS_WB2);
              pg8::Gemm g{H, (const bf16*)(wbf + WB_WI), TOK, 2 * DFF, DM, DM}; pg8::PanelOrder S; S.init(nM, 2 * DFF / 256, F.G, F.bid, mode);
              REPEAT(REP_WI) pg8::EpiSwiglu E{(bf16*)(R + R_MID), DFF, dry}; pg8::gemm_phase<pg8::EpiSwiglu, pg8::PanelOrder, true, true>(ldsl, g, S, E); REPEAT_END
            PH_END
            PH_BEGIN
              const unsigned char* wbf = ws + ((f == 0) ? ((l == 1 && F.G >= 256) ? WS_WB4 : WS_WB) : WS_WB2);
              pg8::Gemm g{(const bf16*)(R + R_MID), (const bf16*)(wbf + WB_WO), TOK, DM, DFF, DFF}; pg8::PanelOrder S; S.init(nM, DM / 256, F.G, F.bid, mode);
              const bool first = (l == 0 && f == 0);
              const int pli = f == 0 ? (l * 3 - 1) : (l * 3 + 1);
              const float* lg_ = first ? (const float*)(ws + WS_IDLN) : args.in[I_LNG] + pli * DM; const float* lb_ = first ? (const float*)(ws + WS_IDLN) + DM : args.in[I_LNB] + pli * DM;
              REPEAT(REP_WO) pg8::EpiResid E{X, modl + (f == 0 ? 2 : 8) * DM, DN_ALPHA, 0.5f, dry, STATS, lg_, lb_};
              pg8::gemm_phase<pg8::EpiResid, pg8::PanelOrder, true, true>(ldsl, g, S, E); REPEAT_END
            PH_END
            PH_BEGIN
              const int li = f == 0 ? 0 : 2; const float* g_ = args.in[I_LNG] + (l * 3 + li) * DM; const float* b_ = args.in[I_LNB] + (l * 3 + li) * DM;
              REPEAT(REP_LN)
              if (f == 0) { ln_pass(F, X, STATS, g_, b_, modl, 3, H, nullptr, false, dry); convert_mix(F, args, l, WB, 0, F.bid, F.G); }
              else if (!last) { ln_pass(F, X, STATS, g_, b_, modl + (size_t)9 * NMOD, 0, H, nullptr, false, dry); if (F.G < 256) convert_ffn(F, args.in[I_F1WI] + (size_t)(l + 1) * DM * 2 * DFF, args.in[I_F1WO] + (size_t)(l + 1) * DFF * DM, WB, F.bid, F.G); }
              else ln_pass(F, X, STATS, g_, b_, nullptr, 0, nullptr, args.out, true, dry);
              REPEAT_END
            PH_END
            if (f == 0) {
                const int mmode = last ? 1 : 0, mM = last ? 128 : NPAN;
                PH_BEGIN
                  pg8::Gemm g{H, (const bf16*)(WB + WB_WIN), TOK, NZ, DM, DM}; pg8::PanelOrder S; S.init(NPAN, NZ / 256, F.G, F.bid, 0); pg8::EpiStore E{(bf16*)(R + R_Z), NZ};
                  REPEAT(REP_WIN) pg8::gemm_phase<pg8::EpiStore, pg8::PanelOrder, true, true>(ldsl, g, S, E); REPEAT_END
                PH_END
                PH_BEGIN
                  MIXPTRS();
#pragma unroll 1
                  REPEAT(REP_PREP) for (int ti = F.bid; ti < NBATCH * (SA / 32); ti += F.G) prep_tile<32>(F, args, l, P, WB, (const float*)(ws + WS_ROPE), ti, dry, 2); REPEAT_END
                  if (F.G < 256) { for (int ti = F.bid; ti < NBATCH * 68; ti += F.G) prep_tile<64>(F, args, l, P, WB, (const float*)(ws + WS_ROPE), ti, 0, 1); }
                  { const int rem = (NBATCH * (SA / 32)) % F.G;
                    __syncthreads(); if (rem == 0) convert_mix(F, args, l, WB, 1, F.bid, F.G); else if (F.bid >= rem) convert_mix(F, args, l, WB, 1, F.bid - rem, F.G - rem); }
                PH_END
                PH_BEGIN
                  MIXPTRS();
                  const int nu = last ? 1024 : 1088;
                  const bool split = (F.G >= 256);
                  const int nsc = split ? 128 : F.G, nat = split ? F.G - 128 : F.G, ia = split ? F.bid - 128 : F.bid;
                  if (!split || F.bid >= 128) {
#pragma unroll 1
                    REPEAT(REP_ATT) for (int u = ia; u < nu; u += nat) attention_unit(F, args, l, (bf16*)(R + R_Z), u, dry); REPEAT_END
                    if (split) { __syncthreads();
#pragma unroll 1
                      for (int ti = ia; ti < NBATCH * 68; ti += nat) prep_tile<64>(F, args, l, P, WB, (const float*)(ws + WS_ROPE), ti, 0, 1);
                      convert_ffn(F, args.in[I_F2WI] + (size_t)l * DM * 2 * DFF, args.in[I_F2WO] + (size_t)l * DFF * DM, ws + WS_WB2, ia, nat); }
                  }
                  if (!split || F.bid < 128) {
#pragma unroll 1
                    REPEAT(REP_SCAN) for (int u = F.bid; u < 128; u += nsc) scan_unit(F, args, l, P, u); REPEAT_END
                  }
                PH_END
                PH_BEGIN
                  MIXPTRS();
                  REPEAT(REP_RWO) rwkv_out(F, args, l, P, last, dry); REPEAT_END
                PH_END
#pragma unroll 1
                for (int i2 = 0; i2 < 8; ++i2) {
                    const int i = i2 >> 1;
                    PH_BEGIN
                      if ((i2 & 1) == 0) {
                        const bf16* Ai = i == 0 ? (const bf16*)(R + R_POOL) : i == 1 ? (const bf16*)(R + R_RWR) : i == 2 ? (const bf16*)(R + R_Z) + ZC_WIN : (const bf16*)(R + R_Z) + ZC_DENSE; const int lda = i < 2 ? 512 : NZ;
                        pg8::Gemm g{Ai, (const bf16*)(WB + WB_WUP) + (size_t)i * DM * 512, TOK, DM, 512, lda}; pg8::PanelOrder S; S.init(mM, DM / 256, F.G, F.bid, mmode); pg8::EpiStoreP E{(bf16*)(R + R_UBUF), DM / 256};
                        REPEAT(REP_U) pg8::gemm_phase<pg8::EpiStoreP, pg8::PanelOrder, true, true>(ldsl, g, S, E); REPEAT_END
                      } else {
                        pg8::Gemm g{H, (const bf16*)(WB + WB_WG) + (size_t)i * DM * DM, TOK, DM, DM, DM}; pg8::PanelOrder S; S.init(mM, DM / 256, F.G, F.bid, mmode);
                        REPEAT(REP_G) pg8::EpiGate E{(bf16*)(R + R_ACC), (bf16*)(R + R_O0), (bf16*)(R + R_RWA1), (const bf16*)(R + R_UBUF), args.in[I_BGATE] + (size_t)l * 4 * DM + i * DM, i == 0 ? 1 : 0, i == 3 ? 1 : 0, dry};
                        pg8::gemm_phase<pg8::EpiGate, pg8::PanelOrder, true, true>(ldsl, g, S, E); REPEAT_END
                      }
                    }
                    asm volatile("s_waitcnt vmcnt(0)" ::: "memory"); __syncthreads();
                }
                PH_BEGIN
                  if (!last && F.G >= 256 && F.bid >= 128) convert_ffn(F, args.in[I_F1WI] + (size_t)(l + 1) * DM * 2 * DFF, args.in[I_F1WO] + (size_t)(l + 1) * DFF * DM, ws + WS_WB4, F.bid - 128, F.G - 128);
                }
                GRID_BARRIER();
                PH_BEGIN
                  pg8::Gemm g{(const bf16*)(R + R_ACC), (const bf16*)(WB + WB_WOUT), TOK, DM, DM, DM}; pg8::PanelOrder S; S.init(mM, DM / 256, F.G, F.bid, mmode);
                  REPEAT(REP_WOUT) pg8::EpiResid E{X, modl + 5 * DM, DN_ALPHA, 1.0f, dry, STATS, args.in[I_LNG] + (l * 3) * DM, args.in[I_LNB] + (l * 3) * DM};
                  pg8::gemm_phase<pg8::EpiResid, pg8::PanelOrder, true, true>(ldsl, g, S, E); REPEAT_END
                PH_END
                PH_BEGIN
                  const float* g_ = args.in[I_LNG] + (l * 3 + 1) * DM; const float* b_ = args.in[I_LNB] + (l * 3 + 1) * DM;
                  REPEAT(REP_LN) ln_pass(F, X, STATS, g_, b_, modl, 6, H, nullptr, last, dry);
                  if (F.G < 256) convert_ffn(F, args.in[I_F2WI] + (size_t)l * DM * 2 * DFF, args.in[I_F2WO] + (size_t)l * DFF * DM, ws + WS_WB2, F.bid, F.G); REPEAT_END
                PH_END
            }
        }
    }
}

extern "C" void kernel_launch(void* const* d_in, const int* in_sizes, int n_in, void* d_out, int out_size, void* d_ws, size_t ws_size, hipStream_t stream) {
    static int grid = 0;
    if (grid == 0) {
        if (n_in != 32 || in_sizes[0] != NBATCH * SEQ * DM || out_size != NBATCH * SEQ * DM || ws_size < WS_END) {
            fprintf(stderr, "kernel_launch: shape / workspace mismatch (n_in %d, in0 %d, out %d, ws %zu, need %zu); nothing launched\n", n_in, n_in > 0 ? in_sizes[0] : -1, out_size, ws_size, (size_t)WS_END); grid = -1; return; }
        int dev = 0, cus = 0, per_cu = 0;
        if (hipGetDevice(&dev) != hipSuccess || hipDeviceGetAttribute(&cus, hipDeviceAttributeMultiprocessorCount, dev) != hipSuccess) { grid = -1; return; }
        if (hipFuncSetAttribute((const void*)fwd_kernel, hipFuncAttributeMaxDynamicSharedMemorySize, LDS_BYTES) != hipSuccess) { fprintf(stderr, "kernel_launch: hipFuncSetAttribute failed\n"); grid = -1; return; }
        if (hipOccupancyMaxActiveBlocksPerMultiprocessor(&per_cu, (const void*)fwd_kernel, NTHR, LDS_BYTES) != hipSuccess || per_cu < 1) fprintf(stderr, "kernel_launch: occupancy query reports %d\n", per_cu);
        (void)hipGetLastError();
        grid = cus;
    }
    if (grid < 0) return;
    if (hipMemsetAsync((char*)d_ws + WS_CTL, 0, CTL_ZERO_BYTES, stream) != hipSuccess) return;
    Args a{};
    for (int i = 0; i < 32; ++i) a.in[i] = (const float*)d_in[i];
    a.out = (float*)d_out; a.ws = (unsigned char*)d_ws;
    hipLaunchKernelGGL(fwd_kernel, dim3(grid), dim3(NTHR), LDS_BYTES, stream, a);
}
```

```cpp
#include <hip/hip_runtime.h>
#include <cstdio>
#include <cstdint>

namespace pg8 {
#define PG8_LAS __attribute__((address_space(3)))
typedef unsigned short bf16_t;
typedef short bf16x8 __attribute__((ext_vector_type(8)));
typedef float f32x4 __attribute__((ext_vector_type(4)));
typedef unsigned u32x4 __attribute__((ext_vector_type(4)));
constexpr int BM = 256, BK = 64, HALF = 128, HTB = HALF * BK * 2  , STAGE_BYTES = 8 * HTB, NXCD = 8, WGM = 4;

__host__ __device__ __forceinline__ int lds_byte(int r, int c) { const int st = (r >> 4) * 2 + (c >> 5), rr = r & 15, cc = c & 31, ob = rr * 64 + cc * 2; return st * 1024 + (ob ^ (((ob >> 9) & 1) << 5)); }
__host__ __device__ __forceinline__ void stage_rc(int b, int& R, int& C) { const int st = b / 1024, sb = b % 1024, swz = sb ^ (((sb >> 9) & 1) << 5); R = (st >> 1) * 16 + swz / 64; C = (st & 1) * 32 + (swz % 64) / 2; }
__host__ __device__ __forceinline__ int perm32(int rho) { const int n = rho >> 4, i = rho & 15; return 8 * (i >> 2) + 4 * n + (i & 3); }

struct Unit { int pm, pn, half; };
struct Gemm { const bf16_t* A; const bf16_t* Bt; int M, N, K, lda; };

struct PanelOrder {
    int nM, nN, nwg, G, c, mode;
    __device__ void init(int nM_, int nN_, int G_, int c_, int mode_) { nM = nM_; nN = nN_; nwg = nM * nN; G = G_; c = c_; mode = mode_; }
    __device__ bool next(int i, Unit& u) const {
        const int full = (nwg / G) * G, T = nwg - full;
        long L = (long)i * G + c; int half = 0;
        if (L >= full) { if (L >= (long)full + G) return false; const int ti = (int)(L - full);
            if (T > 0 && 2 * T <= G && (G & 15) == 0) { const int p = (ti >> 4) * 8 + (ti & 7); if (p >= T) return false; L = full + p; half = 1 + ((ti >> 3) & 1); }
            else if (ti >= T) return false; }
        int wgid = (int)L; { const int q = nwg / NXCD, r = nwg % NXCD, xcd = wgid % NXCD, off = wgid / NXCD; wgid = (xcd < r ? xcd * (q + 1) : r * (q + 1) + (xcd - r) * q) + off; }
        const int nig = WGM * nN, gid = wgid / nig, fm = gid * WGM, gsz = (nM - fm) < WGM ? (nM - fm) : WGM;
        int pm = fm + ((wgid % nig) % gsz); u.pn = (wgid % nig) / gsz;
        if (mode == 1) pm = (pm >> 4) * 17 + 1 + (pm & 15);
        u.pm = pm; u.half = half; return true;
    }
    __device__ __forceinline__ void a_ready(const Unit&) const {}
    __device__ __forceinline__ void done(const Unit&) const {}
};

typedef float f32x2c_ __attribute__((ext_vector_type(2))); typedef __bf16 bf16x2c_ __attribute__((ext_vector_type(2)));
__device__ __forceinline__ unsigned cvt_pk_bf16(float lo, float hi) { const f32x2c_ v = {lo, hi}; const bf16x2c_ b = __builtin_convertvector(v, bf16x2c_); return __builtin_bit_cast(unsigned, b); }
__device__ __forceinline__ float bf_lo(unsigned w) { return __uint_as_float(w << 16); }
__device__ __forceinline__ float bf_hi(unsigned w) { return __uint_as_float(w & 0xffff0000u); }
__device__ __forceinline__ float fast_sigmoid(float x) { return __builtin_amdgcn_rcpf(1.0f + __builtin_amdgcn_exp2f(-1.4426950408889634f * x)); }


struct EpiStore {
    static constexpr bool PERM = true, AFTER_DRAIN = false;
    bf16_t* O; int ldc;
    __device__ __forceinline__ void operator()(const f32x4 (&acc)[2][2][4][2], const Unit& u, int wr, int wc, int fr, int fq) const {
        const int row0 = u.pm * BM + wr * 64 + fr, col0 = u.pn * BM + wc * 32 + 8 * fq;
#pragma unroll
        for (int ai = 0; ai < 2; ++ai) { if (u.half && u.half != ai + 1) continue;
#pragma unroll
            for (int m = 0; m < 4; ++m) { bf16_t* rowp = O + (size_t)(row0 + ai * HALF + m * 16) * ldc + col0;
#pragma unroll
                for (int bj = 0; bj < 2; ++bj) { const f32x4 v0 = acc[ai][bj][m][0], v1 = acc[ai][bj][m][1];
                    u32x4 w; w.x = cvt_pk_bf16(v0[0], v0[1]); w.y = cvt_pk_bf16(v0[2], v0[3]); w.z = cvt_pk_bf16(v1[0], v1[1]); w.w = cvt_pk_bf16(v1[2], v1[3]);
                    *(u32x4*)(rowp + bj * HALF) = w; } } }
    }
};
struct EpiStoreP {
    static constexpr bool PERM = true, AFTER_DRAIN = false;
    bf16_t* O; int nN;
    __device__ __forceinline__ void operator()(const f32x4 (&acc)[2][2][4][2], const Unit& u, int wr, int wc, int fr, int fq) const {
        const int t = ((wr * 4 + wc) * 64) + fq * 16 + fr;
        bf16_t* base = O + ((size_t)(u.pm * nN + u.pn) * 16) * 4096 + t * 8;
#pragma unroll
        for (int ai = 0; ai < 2; ++ai) { if (u.half && u.half != ai + 1) continue;
#pragma unroll
            for (int m = 0; m < 4; ++m)
#pragma unroll
                for (int bj = 0; bj < 2; ++bj) { const f32x4 v0 = acc[ai][bj][m][0], v1 = acc[ai][bj][m][1];
                    u32x4 w; w.x = cvt_pk_bf16(v0[0], v0[1]); w.y = cvt_pk_bf16(v0[2], v0[3]); w.z = cvt_pk_bf16(v1[0], v1[1]); w.w = cvt_pk_bf16(v1[2], v1[3]);
                    *(u32x4*)(base + ((ai * 4 + m) * 2 + bj) * 4096) = w; } }
    }
};
struct EpiSwiglu {
    static constexpr bool PERM = true, AFTER_DRAIN = false;
    bf16_t* O; int ldc; int dry;
    __device__ __forceinline__ void operator()(const f32x4 (&acc)[2][2][4][2], const Unit& u, int wr, int wc, int fr, int fq) const {
        const int row0 = u.pm * BM + wr * 64 + fr, col0 = u.pn * HALF + wc * 32 + 8 * fq;
#pragma unroll
        for (int ai = 0; ai < 2; ++ai) { if (u.half && u.half != ai + 1) continue;
#pragma unroll
            for (int m = 0; m < 4; ++m) { bf16_t* rowp = O + (size_t)(row0 + ai * HALF + m * 16) * ldc + col0;
                float o[8];
#pragma unroll
                for (int n = 0; n < 2; ++n)
#pragma unroll
                    for (int j = 0; j < 4; ++j) { const float gt = acc[ai][0][m][n][j], up = acc[ai][1][m][n][j]; o[n * 4 + j] = gt * fast_sigmoid(gt) * up; }
                u32x4 w; w.x = cvt_pk_bf16(o[0], o[1]); w.y = cvt_pk_bf16(o[2], o[3]); w.z = cvt_pk_bf16(o[4], o[5]); w.w = cvt_pk_bf16(o[6], o[7]);
                if (!dry) *(u32x4*)rowp = w; else asm volatile("" :: "v"(w)); } }
    }
};
struct EpiResid {
    static constexpr bool PERM = true, AFTER_DRAIN = false;
    _Float16* X;
    const float* gate;
    float alpha, scale; int dry;
    const float* stats; const float* lg; const float* lb;
    __device__ __forceinline__ void operator()(const f32x4 (&acc)[2][2][4][2], const Unit& u, int wr, int wc, int fr, int fq) const {
        typedef float f32x2 __attribute__((ext_vector_type(2))); typedef _Float16 f16x4 __attribute__((ext_vector_type(4))); typedef _Float16 f16x8 __attribute__((ext_vector_type(8)));
        const int b = u.pm / 17, p = u.pm - b * 17, bi = (p == 0) ? 8 : b;
        _Float16* dst = X + (size_t)u.pm * BM * 2048;
        const int rl0 = wr * 64 + fr, col0 = u.pn * BM + wc * 32 + 8 * fq;
        const float* gp = gate + (size_t)bi * 9 * 2048 + col0;
        const float* stp = stats + 2 * (size_t)(u.pm * BM + rl0);
#define RESID_ROW(ai_, m_, stv_, raw_) do { \
            const f32x4 v0 = __builtin_convertvector(__builtin_shufflevector(raw_, raw_, 0, 1, 2, 3), f32x4), v1 = __builtin_convertvector(__builtin_shufflevector(raw_, raw_, 4, 5, 6, 7), f32x4); \
            const f32x4 r0 = ((v0 - stv_.x) * stv_.y * lgv0 + lbv0) * alpha + gv0 * acc[ai_][bj][m_][0]; \
            const f32x4 r1 = ((v1 - stv_.x) * stv_.y * lgv1 + lbv1) * alpha + gv1 * acc[ai_][bj][m_][1]; \
            const f16x4 h0 = __builtin_convertvector(r0, f16x4), h1 = __builtin_convertvector(r1, f16x4); \
            const f16x8 rh_ = __builtin_shufflevector(h0, h1, 0, 1, 2, 3, 4, 5, 6, 7); \
            const unsigned off_ = (unsigned)(rl0 + (ai_) * HALF + (m_) * 16) * 2048u + (unsigned)(col0 + co); \
            if (!dry) *(f16x8*)(dst + off_) = rh_; else asm volatile("" :: "v"(rh_)); } while (0)
#pragma unroll
        for (int bj = 0; bj < 2; ++bj) { const int co = bj * HALF;
            const f32x4 gv0 = *(const f32x4*)(gp + co) * scale, lgv0 = *(const f32x4*)(lg + col0 + co), lbv0 = *(const f32x4*)(lb + col0 + co);
            const f32x4 gv1 = *(const f32x4*)(gp + co + 4) * scale, lgv1 = *(const f32x4*)(lg + col0 + co + 4), lbv1 = *(const f32x4*)(lb + col0 + co + 4);
            if (u.half == 0) {
                f32x2 stv[2][4]; f16x8 raw[2][4];
#pragma unroll
                for (int ai = 0; ai < 2; ++ai)
#pragma unroll
                    for (int m = 0; m < 4; ++m) { stv[ai][m] = *(const f32x2*)(stp + 2 * (ai * HALF + m * 16)); raw[ai][m] = *(const f16x8*)(dst + (unsigned)(rl0 + ai * HALF + m * 16) * 2048u + (unsigned)(col0 + co)); }
#pragma unroll
                for (int ai = 0; ai < 2; ++ai)
#pragma unroll
                    for (int m = 0; m < 4; ++m) RESID_ROW(ai, m, stv[ai][m], raw[ai][m]);
            } else {
#pragma unroll
                for (int ai = 0; ai < 2; ++ai) { if (u.half != ai + 1) continue;
                    f32x2 stv[4]; f16x8 raw[4];
#pragma unroll
                    for (int m = 0; m < 4; ++m) { stv[m] = *(const f32x2*)(stp + 2 * (ai * HALF + m * 16)); raw[m] = *(const f16x8*)(dst + (unsigned)(rl0 + ai * HALF + m * 16) * 2048u + (unsigned)(col0 + co)); }
#pragma unroll
                    for (int m = 0; m < 4; ++m) RESID_ROW(ai, m, stv[m], raw[m]); }
            }
            asm volatile("" ::: "memory"); }
#undef RESID_ROW
    }
};
struct EpiGate {
    static constexpr bool PERM = true, AFTER_DRAIN = false;
    bf16_t* ACCF; bf16_t* ACCP0; bf16_t* ACCP1; const bf16_t* U; const float* bias; int first; int lastb; int dry;
    __device__ __forceinline__ void operator()(const f32x4 (&acc)[2][2][4][2], const Unit& u, int wr, int wc, int fr, int fq) const {
        const int row0 = u.pm * BM + wr * 64 + fr, col0 = u.pn * BM + wc * 32 + 8 * fq;
        const int t = ((wr * 4 + wc) * 64) + fq * 16 + fr, k = u.pm * 8 + u.pn;
        const bf16_t* ub = U + (size_t)k * 65536 + t * 8;
        bf16_t* pb = (k < 544 ? ACCP0 + (size_t)k * 65536 : ACCP1 + (size_t)(k - 544) * 65536) + t * 8;
        f32x4 bv[2][2];
#pragma unroll
        for (int bj = 0; bj < 2; ++bj)
#pragma unroll
            for (int n = 0; n < 2; ++n) bv[bj][n] = *(const f32x4*)(bias + col0 + bj * HALF + 4 * n);
        const bool lz = lastb != 0; const unsigned keep = first ? 0u : 0xffffffffu;
        const int oSA = lz ? HALF * 2048 : 8 * 4096, oSM = lz ? 16 * 2048 : 2 * 4096, oSB = lz ? HALF : 4096; bf16_t* ob0 = lz ? ACCF + (size_t)row0 * 2048 + col0 : pb;
#pragma unroll
        for (int ai = 0; ai < 2; ++ai) { if (u.half && u.half != ai + 1) continue;
            u32x4 uq[4][2], pq[4][2];
#pragma unroll
            for (int m = 0; m < 4; ++m)
#pragma unroll
                for (int bj = 0; bj < 2; ++bj) { const int off = ((ai * 4 + m) * 2 + bj) * 4096; uq[m][bj] = *(const u32x4*)(ub + off); pq[m][bj] = *(const u32x4*)(pb + off); }
#pragma unroll
            for (int m = 0; m < 4; ++m)
#pragma unroll
                for (int bj = 0; bj < 2; ++bj) {
                    const u32x4 uv = uq[m][bj]; u32x4 pv = pq[m][bj]; pv.x &= keep; pv.y &= keep; pv.z &= keep; pv.w &= keep;
                    const f32x4 g0 = acc[ai][bj][m][0] + bv[bj][0], g1 = acc[ai][bj][m][1] + bv[bj][1];
                    float o[8];
                    o[0] = bf_lo(pv.x) + fast_sigmoid(g0[0]) * bf_lo(uv.x); o[1] = bf_hi(pv.x) + fast_sigmoid(g0[1]) * bf_hi(uv.x);
                    o[2] = bf_lo(pv.y) + fast_sigmoid(g0[2]) * bf_lo(uv.y); o[3] = bf_hi(pv.y) + fast_sigmoid(g0[3]) * bf_hi(uv.y);
                    o[4] = bf_lo(pv.z) + fast_sigmoid(g1[0]) * bf_lo(uv.z); o[5] = bf_hi(pv.z) + fast_sigmoid(g1[1]) * bf_hi(uv.z);
                    o[6] = bf_lo(pv.w) + fast_sigmoid(g1[2]) * bf_lo(uv.w); o[7] = bf_hi(pv.w) + fast_sigmoid(g1[3]) * bf_hi(uv.w);
                    u32x4 w; w.x = cvt_pk_bf16(o[0], o[1]); w.y = cvt_pk_bf16(o[2], o[3]); w.z = cvt_pk_bf16(o[4], o[5]); w.w = cvt_pk_bf16(o[6], o[7]);
                    if (!dry) *(u32x4*)(ob0 + (ai * oSA + m * oSM + bj * oSB)) = w; else asm volatile("" :: "v"(w)); }
            asm volatile("" ::: "memory"); }
    }
};

template <class Epi, class Sched, bool ALIGN_EPI = false, bool SP2 = false>
__device__ __forceinline__ void gemm_phase(PG8_LAS unsigned char* lds, const Gemm g, const Sched& S, const Epi& E) {
    int tid_ = threadIdx.x; asm volatile("" : "+v"(tid_));
    float zz_ = 0.f; asm volatile("" : "+v"(zz_));
    const int tid = tid_, wid = __builtin_amdgcn_readfirstlane(tid >> 6), lane = tid & 63, wr = wid >> 2, wc = wid & 3, fr = lane & 15, fq = lane >> 4;
    const int K = g.K, nt = K / BK;
    unsigned voffA[2], voffB[2];
#pragma unroll
    for (int i = 0; i < 2; ++i) { int R, C; stage_rc(tid * 16 + i * 8192, R, C); const int Rb = Epi::PERM ? ((R & ~31) + perm32(R & 31)) : R;
        voffA[i] = (unsigned)(R * g.lda + C) * 2u; voffB[i] = (unsigned)(Rb * K + C) * 2u; }
    const size_t kstep = (size_t)(BK * 2);
    const size_t hstepB = (size_t)HALF * K * 2, hstepA = (size_t)HALF * g.lda * 2;
    const size_t tstepB = 2 * hstepB, tstepA = 2 * hstepA;
    const unsigned ldsw = (unsigned)wid * 1024u;
    const int aoff = lds_byte(wr * 64 + fr, fq * 8), boff = lds_byte(wc * 32 + fr, fq * 8);
#define PG8_SA(b, h) (((b) * 2 + (h)) * HTB)
#define PG8_SB(b, h) ((4 + (b) * 2 + (h)) * HTB)
#define PG8_STAGE(bufoff, gbase, voff) do { _Pragma("unroll") for (int _i = 0; _i < 2; ++_i) \
        __builtin_amdgcn_global_load_lds((const unsigned*)((const char*)(gbase) + (voff)[_i]), (PG8_LAS unsigned*)(lds + (bufoff) + ldsw + _i * 8192), 16, 0, 0); } while (0)
#define PG8_LDA(dst, b, h) do { _Pragma("unroll") for (int m = 0; m < 4; ++m) _Pragma("unroll") for (int k = 0; k < 2; ++k) dst[m][k] = *(const PG8_LAS bf16x8*)(lds + PG8_SA(b, h) + aoff + m * 2048 + k * 1024); } while (0)
#define PG8_LDB(dst, b, h) do { _Pragma("unroll") for (int n = 0; n < 2; ++n) _Pragma("unroll") for (int k = 0; k < 2; ++k) dst[n][k] = *(const PG8_LAS bf16x8*)(lds + PG8_SB(b, h) + boff + n * 2048 + k * 1024); } while (0)
#define PG8_MMA(ai, bj, At, Bt) do { __builtin_amdgcn_s_setprio(1); _Pragma("unroll") for (int m = 0; m < 4; ++m) _Pragma("unroll") for (int n = 0; n < 2; ++n) _Pragma("unroll") for (int k = 0; k < 2; ++k) \
        acc[ai][bj][m][n] = __builtin_amdgcn_mfma_f32_16x16x32_bf16(Bt[n][k], At[m][k], acc[ai][bj][m][n], 0, 0, 0); __builtin_amdgcn_s_setprio(0); } while (0)
#define PG8_WAIT_V(n) asm volatile("s_waitcnt vmcnt(" #n ")" ::: "memory")
#define PG8_WAIT_L(n) asm volatile("s_waitcnt lgkmcnt(" #n ")" ::: "memory")
#define PG8_BAR __builtin_amdgcn_s_barrier()
#define PG8_SCHED __builtin_amdgcn_sched_barrier(0)
    Unit cur, nxt; int ui = 0;
    if (!S.next(0, cur)) return;
    f32x4 acc[2][2][4][2];
#pragma unroll
    for (int a = 0; a < 2; ++a)
#pragma unroll
        for (int b = 0; b < 2; ++b)
#pragma unroll
            for (int m = 0; m < 4; ++m)
#pragma unroll
                for (int n = 0; n < 2; ++n) acc[a][b][m][n] = (f32x4){zz_, zz_, zz_, zz_};
    bf16x8 At[4][2], B0[2][2], B1[2][2];
    const char* cA = (const char*)g.A + (size_t)cur.pm * tstepA; const char* cB = (const char*)g.Bt + (size_t)cur.pn * tstepB;
    S.a_ready(cur);
    if constexpr (SP2) {
        PG8_STAGE(PG8_SB(0, 0), cB, voffB); PG8_STAGE(PG8_SB(0, 1), cB + hstepB, voffB); PG8_STAGE(PG8_SA(0, 0), cA, voffA); PG8_STAGE(PG8_SA(0, 1), cA + hstepA, voffA);
        if (wr == 1) PG8_BAR;
        PG8_WAIT_V(2); PG8_BAR;
        PG8_STAGE(PG8_SB(1, 0), cB + kstep, voffB); PG8_STAGE(PG8_SA(1, 0), cA + kstep, voffA); PG8_STAGE(PG8_SB(1, 1), cB + hstepB + kstep, voffB);
        PG8_WAIT_V(6); PG8_BAR;
    } else {
        PG8_STAGE(PG8_SB(0, 0), cB, voffB); PG8_STAGE(PG8_SA(0, 0), cA, voffA); PG8_STAGE(PG8_SB(0, 1), cB + hstepB, voffB); PG8_STAGE(PG8_SA(0, 1), cA + hstepA, voffA);
        if (wr == 1) PG8_BAR;
        PG8_WAIT_V(4); PG8_BAR;
        PG8_STAGE(PG8_SB(1, 0), cB + kstep, voffB); PG8_STAGE(PG8_SA(1, 0), cA + kstep, voffA); PG8_STAGE(PG8_SB(1, 1), cB + hstepB + kstep, voffB);
        PG8_WAIT_V(6); PG8_BAR;
    }
    for (;;) {
        const bool has_next = S.next(ui + 1, nxt);
        const char* nA = has_next ? (const char*)g.A + (size_t)nxt.pm * tstepA : cA; const char* nB = has_next ? (const char*)g.Bt + (size_t)nxt.pn * tstepB : cB;
        if (cur.half == 0) {
        for (int t = 0; t < nt; t += 2) {
            const bool last = (t == nt - 2);
            const char* a1 = cA + (size_t)(t + 1) * kstep;
            const char* a2 = last ? nA : cA + (size_t)(t + 2) * kstep; const char* b2 = last ? nB : cB + (size_t)(t + 2) * kstep;
            const char* a3 = a2 + kstep; const char* b3 = b2 + kstep;
            if (last && has_next) S.a_ready(nxt);
            if constexpr (SP2) {
            PG8_LDB(B0, 0, 0); PG8_LDB(B1, 0, 1); PG8_SCHED; PG8_LDA(At, 0, 0); PG8_STAGE(PG8_SA(1, 1), a1 + hstepA, voffA);
            PG8_WAIT_V(8); PG8_WAIT_L(0); PG8_BAR; PG8_MMA(0, 0, At, B0); PG8_MMA(0, 1, At, B1); PG8_BAR; PG8_SCHED;
            PG8_LDA(At, 0, 1); PG8_STAGE(PG8_SB(0, 0), b2, voffB); PG8_STAGE(PG8_SB(0, 1), b2 + hstepB, voffB); PG8_STAGE(PG8_SA(0, 0), a2, voffA);
            PG8_WAIT_V(8); PG8_WAIT_L(0); PG8_BAR; PG8_MMA(1, 0, At, B0); PG8_MMA(1, 1, At, B1); PG8_BAR; PG8_SCHED;
            PG8_LDB(B0, 1, 0); PG8_LDB(B1, 1, 1); PG8_SCHED; PG8_LDA(At, 1, 0); PG8_STAGE(PG8_SA(0, 1), a2 + hstepA, voffA);
            PG8_WAIT_V(8); PG8_WAIT_L(0); PG8_BAR; PG8_MMA(0, 0, At, B0); PG8_MMA(0, 1, At, B1); PG8_BAR; PG8_SCHED;
            PG8_LDA(At, 1, 1); PG8_STAGE(PG8_SB(1, 0), b3, voffB); PG8_STAGE(PG8_SB(1, 1), b3 + hstepB, voffB); PG8_STAGE(PG8_SA(1, 0), a3, voffA);
            PG8_WAIT_V(8); PG8_WAIT_L(0); PG8_BAR; PG8_MMA(1, 0, At, B0); PG8_MMA(1, 1, At, B1); PG8_BAR; PG8_SCHED;
            } else {
            PG8_LDB(B0, 0, 0); PG8_SCHED; PG8_LDA(At, 0, 0); PG8_STAGE(PG8_SA(1, 1), a1 + hstepA, voffA);
            PG8_WAIT_L(8); PG8_BAR; PG8_WAIT_L(0); PG8_MMA(0, 0, At, B0); PG8_BAR; PG8_SCHED;
            PG8_LDB(B1, 0, 1); PG8_STAGE(PG8_SB(0, 0), b2, voffB);
            PG8_BAR; PG8_WAIT_L(0); PG8_MMA(0, 1, At, B1); PG8_BAR;
            PG8_LDA(At, 0, 1); PG8_STAGE(PG8_SA(0, 0), a2, voffA);
            PG8_BAR; PG8_WAIT_L(0); PG8_MMA(1, 0, At, B0); PG8_BAR; PG8_SCHED;
            PG8_STAGE(PG8_SB(0, 1), b2 + hstepB, voffB);
            PG8_WAIT_V(6); PG8_BAR; PG8_MMA(1, 1, At, B1); PG8_BAR;
            PG8_LDB(B0, 1, 0); PG8_SCHED; PG8_LDA(At, 1, 0); PG8_STAGE(PG8_SA(0, 1), a2 + hstepA, voffA);
            PG8_WAIT_L(8); PG8_BAR; PG8_WAIT_L(0); PG8_MMA(0, 0, At, B0); PG8_BAR; PG8_SCHED;
            PG8_LDB(B1, 1, 1); PG8_STAGE(PG8_SB(1, 0), b3, voffB);
            PG8_BAR; PG8_WAIT_L(0); PG8_MMA(0, 1, At, B1); PG8_BAR;
            PG8_LDA(At, 1, 1); PG8_STAGE(PG8_SA(1, 0), a3, voffA);
            PG8_BAR; PG8_WAIT_L(0); PG8_MMA(1, 0, At, B0); PG8_BAR; PG8_SCHED;
            PG8_STAGE(PG8_SB(1, 1), b3 + hstepB, voffB);
            PG8_WAIT_V(6); PG8_BAR; PG8_MMA(1, 1, At, B1); PG8_BAR;
            }
        }
        } else {
        for (int t = 0; t < nt; t += 2) {
            const bool last = (t == nt - 2);
            const char* a1 = cA + (size_t)(t + 1) * kstep;
            const char* a2 = last ? nA : cA + (size_t)(t + 2) * kstep; const char* b2 = last ? nB : cB + (size_t)(t + 2) * kstep;
            const char* a3 = a2 + kstep; const char* b3 = b2 + kstep;
            if (last && has_next) S.a_ready(nxt);
            if constexpr (SP2) {
            PG8_LDB(B0, 0, 0); PG8_LDB(B1, 0, 1); PG8_SCHED; PG8_LDA(At, 0, 0); PG8_STAGE(PG8_SA(1, 1), a1 + hstepA, voffA);
            PG8_WAIT_V(8); PG8_WAIT_L(0); PG8_BAR; if (cur.half != 2) { PG8_MMA(0, 0, At, B0); PG8_MMA(0, 1, At, B1); } PG8_BAR; PG8_SCHED;
            PG8_LDA(At, 0, 1); PG8_STAGE(PG8_SB(0, 0), b2, voffB); PG8_STAGE(PG8_SB(0, 1), b2 + hstepB, voffB); PG8_STAGE(PG8_SA(0, 0), a2, voffA);
            PG8_WAIT_V(8); PG8_WAIT_L(0); PG8_BAR; if (cur.half != 1) { PG8_MMA(1, 0, At, B0); PG8_MMA(1, 1, At, B1); } PG8_BAR; PG8_SCHED;
            PG8_LDB(B0, 1, 0); PG8_LDB(B1, 1, 1); PG8_SCHED; PG8_LDA(At, 1, 0); PG8_STAGE(PG8_SA(0, 1), a2 + hstepA, voffA);
            PG8_WAIT_V(8); PG8_WAIT_L(0); PG8_BAR; if (cur.half != 2) { PG8_MMA(0, 0, At, B0); PG8_MMA(0, 1, At, B1); } PG8_BAR; PG8_SCHED;
            PG8_LDA(At, 1, 1); PG8_STAGE(PG8_SB(1, 0), b3, voffB); PG8_STAGE(PG8_SB(1, 1), b3 + hstepB, voffB); PG8_STAGE(PG8_SA(1, 0), a3, voffA);
            PG8_WAIT_V(8); PG8_WAIT_L(0); PG8_BAR; if (cur.half != 1) { PG8_MMA(1, 0, At, B0); PG8_MMA(1, 1, At, B1); } PG8_BAR; PG8_SCHED;
            } else {
            PG8_LDB(B0, 0, 0); PG8_SCHED; PG8_LDA(At, 0, 0); PG8_STAGE(PG8_SA(1, 1), a1 + hstepA, voffA);
            PG8_WAIT_L(8); PG8_BAR; PG8_WAIT_L(0); PG8_MMA(0, 0, At, B0); PG8_BAR; PG8_SCHED;
            PG8_LDB(B1, 0, 1); PG8_STAGE(PG8_SB(0, 0), b2, voffB);
            PG8_BAR; PG8_WAIT_L(0); PG8_MMA(0, 1, At, B1); PG8_BAR;
            PG8_LDA(At, 0, 1); PG8_STAGE(PG8_SA(0, 0), a2, voffA);
            PG8_BAR; PG8_WAIT_L(0); PG8_MMA(1, 0, At, B0); PG8_BAR; PG8_SCHED;
            PG8_STAGE(PG8_SB(0, 1), b2 + hstepB, voffB);
            PG8_WAIT_V(6); PG8_BAR; PG8_MMA(1, 1, At, B1); PG8_BAR;
            PG8_LDB(B0, 1, 0); PG8_SCHED; PG8_LDA(At, 1, 0); PG8_STAGE(PG8_SA(0, 1), a2 + hstepA, voffA);
            PG8_WAIT_L(8); PG8_BAR; PG8_WAIT_L(0); PG8_MMA(0, 0, At, B0); PG8_BAR; PG8_SCHED;
            PG8_LDB(B1, 1, 1); PG8_STAGE(PG8_SB(1, 0), b3, voffB);
            PG8_BAR; PG8_WAIT_L(0); PG8_MMA(0, 1, At, B1); PG8_BAR;
            PG8_LDA(At, 1, 1); PG8_STAGE(PG8_SA(1, 0), a3, voffA);
            PG8_BAR; PG8_WAIT_L(0); PG8_MMA(1, 0, At, B0); PG8_BAR; PG8_SCHED;
            PG8_STAGE(PG8_SB(1, 1), b3 + hstepB, voffB);
            PG8_WAIT_V(6); PG8_BAR; PG8_MMA(1, 1, At, B1); PG8_BAR;
            }
        }
        }
        if constexpr (ALIGN_EPI) { if (wr == 0) PG8_BAR; }
        if constexpr (!Epi::AFTER_DRAIN) { int fr_e = fr, fq_e = fq; asm volatile("" : "+v"(fr_e), "+v"(fq_e));
            E(acc, cur, wr, wc, fr_e, fq_e); S.done(cur); }
        if (!has_next) break;
#pragma unroll
        for (int a = 0; a < 2; ++a)
#pragma unroll
            for (int b = 0; b < 2; ++b)
#pragma unroll
                for (int m = 0; m < 4; ++m)
#pragma unroll
                    for (int n = 0; n < 2; ++n) acc[a][b][m][n] = (f32x4){zz_, zz_, zz_, zz_};
        cur = nxt; cA = nA; cB = nB; ++ui;
        if constexpr (ALIGN_EPI) { if (wr == 1) PG8_BAR; }
    }
    PG8_WAIT_V(0);
    if constexpr (!ALIGN_EPI) { if (wr == 0) PG8_BAR; }
    PG8_BAR;
    if constexpr (Epi::AFTER_DRAIN) { E.fused(acc, cur, wr, wc, fr, fq, lds, wid, lane); S.done(cur); }
#undef PG8_SA
#undef PG8_SB
#undef PG8_STAGE
#undef PG8_LDA
#undef PG8_LDB
#undef PG8_MMA
#undef PG8_WAIT_V
#undef PG8_WAIT_L
#undef PG8_BAR
#undef PG8_SCHED
}
}

namespace att {
typedef unsigned short bf16;
using bf16x8 = __attribute__((ext_vector_type(8))) short;
using s16x4  = __attribute__((ext_vector_type(4))) short;
using f32x16 = __attribute__((ext_vector_type(16))) float;
using u32x4  = __attribute__((ext_vector_type(4))) unsigned;
constexpr int D = 128, NW = 8, QBLK = 32, KVBLK = 64;
constexpr float SCALE = 0.088388347648318440f;
constexpr float THR = 8.f;
#ifndef ATT_SDEPTH
#define ATT_SDEPTH 1
#endif
constexpr int LDZ = 4864;
constexpr size_t SHM_V = KVBLK * D * 2, SHM_K = KVBLK * D * 2, SHM_ATTN = 2 * SHM_V + 2 * SHM_K + NW * 64 * 4;
#define KSWZ(row, colB) ((row) * 256 + ((colB) ^ (((row) & 7) << 4)))
#define SBAR() __builtin_amdgcn_sched_barrier(0)
__device__ __forceinline__ int crow(int r, int hi) { return (r & 3) + 8 * (r >> 2) + 4 * hi; }
__device__ __forceinline__ unsigned cvtpk(float lo, float hi) { unsigned r; asm volatile("v_cvt_pk_bf16_f32 %0, %1, %2" : "=v"(r) : "v"(lo), "v"(hi)); return r; }

__device__ __forceinline__ void band_mask(f32x16& p0, f32x16& p1, int rel0, int hi) {
#pragma unroll
    for (int r = 0; r < 16; ++r) { const int d0 = rel0 + crow(r, hi), d1 = d0 + 32;
        if (d0 > 128 || d0 < -128) p0[r] = -1e30f;
        if (d1 > 128 || d1 < -128) p1[r] = -1e30f; }
}
__device__ __forceinline__ void partialSM(f32x16& p0, f32x16& p1, float& m_reg, float& mn, float& alpha) {
    constexpr float C = SCALE * 1.4426950408889634f;
    float pmax = p0[0];
#pragma unroll
    for (int r = 1; r < 16; ++r) pmax = fmaxf(pmax, p0[r]);
#pragma unroll
    for (int r = 0; r < 16; ++r) pmax = fmaxf(pmax, p1[r]);
    { auto rr = __builtin_amdgcn_permlane32_swap(__float_as_uint(pmax), __float_as_uint(pmax), false, false);
      pmax = fmaxf(__uint_as_float(rr[0]), __uint_as_float(rr[1])); }
    if (__builtin_expect(__all(pmax - m_reg <= THR / SCALE), 1)) { mn = m_reg; alpha = 1.f; }
    else { mn = fmaxf(m_reg, pmax); alpha = __builtin_amdgcn_exp2f((m_reg - mn) * C); m_reg = mn; }
    float mnC = -mn * C;
#pragma unroll
    for (int r = 0; r < 16; ++r) p0[r] = fmaf(p0[r], C, mnC);
#pragma unroll
    for (int r = 0; r < 16; ++r) p1[r] = fmaf(p1[r], C, mnC);
#pragma unroll
    for (int r = 0; r < 16; ++r) p0[r] = __builtin_amdgcn_exp2f(p0[r]);
}
__device__ __forceinline__ void finishSM(f32x16& p0, f32x16& p1, float alpha, float& l_reg, bf16x8& pa0, bf16x8& pa1, bf16x8& pa2, bf16x8& pa3) {
#pragma unroll
    for (int r = 0; r < 16; ++r) p1[r] = __builtin_amdgcn_exp2f(p1[r]);
    float ps = 0;
#pragma unroll
    for (int r = 0; r < 16; ++r) ps += p0[r];
#pragma unroll
    for (int r = 0; r < 16; ++r) ps += p1[r];
    { auto rr = __builtin_amdgcn_permlane32_swap(__float_as_uint(ps), __float_as_uint(ps), false, false);
      ps = __uint_as_float(rr[0]) + __uint_as_float(rr[1]); }
    l_reg = l_reg * alpha + ps;
#define PK4(P, BASE, OUT) do { unsigned a0 = cvtpk(P[BASE + 0], P[BASE + 1]), a1 = cvtpk(P[BASE + 2], P[BASE + 3]);   \
    unsigned b0 = cvtpk(P[BASE + 4], P[BASE + 5]), b1 = cvtpk(P[BASE + 6], P[BASE + 7]);                              \
    auto r0 = __builtin_amdgcn_permlane32_swap(a0, b0, false, false); auto r1 = __builtin_amdgcn_permlane32_swap(a1, b1, false, false); \
    u32x4 w = {r0[0], r1[0], r0[1], r1[1]}; OUT = *reinterpret_cast<bf16x8*>(&w); } while (0)
    PK4(p0, 0, pa0); PK4(p0, 8, pa1); PK4(p1, 0, pa2); PK4(p1, 8, pa3);
#undef PK4
}
__device__ __forceinline__ void qkt(f32x16& p0, f32x16& p1, const bf16* Ks, const bf16x8* qr, int r32, int hi) {
    p0 = f32x16{}; p1 = f32x16{};
#pragma unroll
    for (int d0 = 0; d0 < 8; ++d0) { int cb = (d0 * 16 + hi * 8) * 2;
        bf16x8 b0 = *reinterpret_cast<const bf16x8*>((const char*)Ks + KSWZ(r32, cb));
        bf16x8 b1 = *reinterpret_cast<const bf16x8*>((const char*)Ks + KSWZ(32 + r32, cb));
        p0 = __builtin_amdgcn_mfma_f32_32x32x16_bf16(b0, qr[d0], p0, 0, 0, 0);
        p1 = __builtin_amdgcn_mfma_f32_32x32x16_bf16(b1, qr[d0], p1, 0, 0, 0); }
}
__device__ __forceinline__ int v_st(int k, int c) { const int kk = (k & ~0xC) | ((k & 4) << 1) | ((k & 8) >> 1); return ((kk >> 3) * 4 + (c >> 5)) * 512 + ((kk & 7) * 32 + (c & 31)) * 2; }
__device__ __forceinline__ int v_rd_base(int lane) { return ((lane & 3) << 3) | (((lane >> 2) & 3) << 6) | (((lane >> 4) & 1) << 5) | (((lane >> 5) & 1) << 8); }
constexpr int v_rd_off(int d0, int ks, int half) { return d0 * 512 + ks * 4096 + half * 2048; }
template <int OFF> __device__ __forceinline__ s16x4 tr_read(int vb) {
    s16x4 r; asm volatile("ds_read_b64_tr_b16 %0, %1 offset:%2" : "=&v"(r) : "v"(vb), "i"(OFF) : "memory"); return r;
}
template <int D0> __device__ __forceinline__ void pv_one(f32x16& od, int vb, bf16x8 pa0, bf16x8 pa1, bf16x8 pa2, bf16x8 pa3) {
    const s16x4 l0 = tr_read<v_rd_off(D0, 0, 0)>(vb), h0 = tr_read<v_rd_off(D0, 0, 1)>(vb), l1 = tr_read<v_rd_off(D0, 1, 0)>(vb), h1 = tr_read<v_rd_off(D0, 1, 1)>(vb);
    const s16x4 l2 = tr_read<v_rd_off(D0, 2, 0)>(vb), h2 = tr_read<v_rd_off(D0, 2, 1)>(vb), l3 = tr_read<v_rd_off(D0, 3, 0)>(vb), h3 = tr_read<v_rd_off(D0, 3, 1)>(vb);
    asm volatile("s_waitcnt lgkmcnt(0)" ::: "memory"); SBAR();
#define PK(L, H) (bf16x8){L[0], L[1], L[2], L[3], H[0], H[1], H[2], H[3]}
    od = __builtin_amdgcn_mfma_f32_32x32x16_bf16(pa0, PK(l0, h0), od, 0, 0, 0);
    od = __builtin_amdgcn_mfma_f32_32x32x16_bf16(pa1, PK(l1, h1), od, 0, 0, 0);
    od = __builtin_amdgcn_mfma_f32_32x32x16_bf16(pa2, PK(l2, h2), od, 0, 0, 0);
    od = __builtin_amdgcn_mfma_f32_32x32x16_bf16(pa3, PK(l3, h3), od, 0, 0, 0);
#undef PK
}
__device__ __forceinline__ void pv_d0(f32x16* o, int vb, bf16x8 pa0, bf16x8 pa1, bf16x8 pa2, bf16x8 pa3) {
    pv_one<0>(o[0], vb, pa0, pa1, pa2, pa3); pv_one<1>(o[1], vb, pa0, pa1, pa2, pa3); pv_one<2>(o[2], vb, pa0, pa1, pa2, pa3); pv_one<3>(o[3], vb, pa0, pa1, pa2, pa3);
}

__device__ __forceinline__ void attn_body(const bool BAND, const bf16* __restrict__ Qb, const bf16* __restrict__ Kh, const bf16* __restrict__ Vh, bf16* __restrict__ Ob,
                                          int NT, int bstart, int qpos0, float m0, float l0, char* lds, const int dry) {
    int tid_ = threadIdx.x; asm volatile("" : "+v"(tid_));
    const int tid = tid_, wid = tid >> 6, lane = tid & 63, r32 = lane & 31, hi = lane >> 5;
    bf16* V_lds = (bf16*)lds; bf16* K_lds = (bf16*)(lds + 2 * SHM_V);
    float* ws = (float*)(lds + 2 * SHM_V + 2 * SHM_K) + wid * 64; float* li_l = ws; float* al_l = ws + 32;
    float m_reg = m0, l_reg = l0; f32x16 o[4] = {}; bf16x8 qr[8];
    const bf16* Qw = Qb + (long)(wid * QBLK + r32) * LDZ + hi * 8;
#pragma unroll
    for (int d0 = 0; d0 < 8; ++d0) qr[d0] = *reinterpret_cast<const bf16x8*>(Qw + d0 * 16);
    const int sr = tid >> 4, sc = (tid & 15) * 8, vst0 = v_st(sr, sc), vst1 = v_st(32 + sr, sc);
    const int vb0 = (int)(uintptr_t)V_lds + v_rd_base(lane);
    const int qrel = qpos0 + wid * QBLK + r32;
    constexpr int SDEPTH = ATT_SDEPTH;
    struct { bf16x8 vs0, vs1, ks0, ks1; } sr_[SDEPTH];
#define KROW(t) ((BAND && (t) >= 4) ? (256 + bstart + ((t) - 4) * KVBLK) : (t) * KVBLK)
#define SLOAD(i, t) do { const int k0_ = KROW(t); sr_[i].vs0 = *reinterpret_cast<const bf16x8*>(&Vh[(long)(k0_ + sr) * LDZ + sc]); sr_[i].vs1 = *reinterpret_cast<const bf16x8*>(&Vh[(long)(k0_ + 32 + sr) * LDZ + sc]); \
    sr_[i].ks0 = *reinterpret_cast<const bf16x8*>(&Kh[(long)(k0_ + sr) * LDZ + sc]); sr_[i].ks1 = *reinterpret_cast<const bf16x8*>(&Kh[(long)(k0_ + 32 + sr) * LDZ + sc]); } while (0)
#define SWRITE(b, i) do { *(bf16x8*)((char*)V_lds + (b) * SHM_V + vst0) = sr_[i].vs0;          \
    *(bf16x8*)((char*)V_lds + (b) * SHM_V + vst1) = sr_[i].vs1; int kc = sc * 2;               \
    *(bf16x8*)((char*)K_lds + (b) * SHM_K + KSWZ(sr, kc)) = sr_[i].ks0;                       \
    *(bf16x8*)((char*)K_lds + (b) * SHM_K + KSWZ(32 + sr, kc)) = sr_[i].ks1; } while (0)
#define SWAIT() do { if constexpr (SDEPTH == 2) asm volatile("s_waitcnt vmcnt(4)" ::: "memory"); else asm volatile("s_waitcnt vmcnt(0)" ::: "memory"); } while (0)
#define RESC(a) do { if (__any((a) < 1.f)) { if (hi == 0) al_l[r32] = (a); asm volatile("s_waitcnt lgkmcnt(0)" ::: "memory"); \
    _Pragma("unroll") for (int d = 0; d < 4; ++d) _Pragma("unroll") for (int r = 0; r < 16; ++r) o[d][r] *= al_l[crow(r, hi)]; } } while (0)
#define MASK(P0, P1, t) do { if (BAND && (t) >= 4) band_mask(P0, P1, bstart + ((t) - 4) * KVBLK - qrel, hi); } while (0)
    f32x16 pA0, pA1, pB0, pB1; float mnA, mnB, alA, alB; bf16x8 pa0, pa1, pa2, pa3;
    constexpr int SE = 0, SO = SDEPTH - 1;
    SLOAD(SE, 0); asm volatile("s_waitcnt vmcnt(0)" ::: "memory"); SWRITE(0, SE); __syncthreads();
    qkt(pA0, pA1, K_lds, qr, r32, hi); MASK(pA0, pA1, 0); partialSM(pA0, pA1, m_reg, mnA, alA);
    SLOAD(SO, 1); if constexpr (SDEPTH == 2) { if (2 < NT) SLOAD(SE, 2); }
    SWAIT(); SWRITE(1, SO); __syncthreads();
    for (int j = 1; j + 1 < NT; j += 2) {
        SBAR(); qkt(pB0, pB1, (bf16*)((char*)K_lds + SHM_K), qr, r32, hi); MASK(pB0, pB1, j);
        finishSM(pA0, pA1, alA, l_reg, pa0, pa1, pa2, pa3); SBAR();
        SLOAD(SO, j + SDEPTH); SBAR();
        pv_d0(o, vb0, pa0, pa1, pa2, pa3); partialSM(pB0, pB1, m_reg, mnB, alB);
        __syncthreads(); SWAIT(); SWRITE(0, SE);
        RESC(alB); __syncthreads();
        SBAR(); qkt(pA0, pA1, K_lds, qr, r32, hi); MASK(pA0, pA1, j + 1);
        finishSM(pB0, pB1, alB, l_reg, pa0, pa1, pa2, pa3); SBAR();
        if (SDEPTH == 1 || j + 3 < NT) SLOAD(SE, j + 1 + SDEPTH); SBAR();
        pv_d0(o, vb0 + (int)SHM_V, pa0, pa1, pa2, pa3); partialSM(pA0, pA1, m_reg, mnA, alA);
        __syncthreads(); SWAIT(); SWRITE(1, SO);
        RESC(alA); __syncthreads();
    }
    SBAR(); qkt(pB0, pB1, (bf16*)((char*)K_lds + SHM_K), qr, r32, hi); MASK(pB0, pB1, NT - 1);
    finishSM(pA0, pA1, alA, l_reg, pa0, pa1, pa2, pa3); SBAR();
    pv_d0(o, vb0, pa0, pa1, pa2, pa3); partialSM(pB0, pB1, m_reg, mnB, alB);
    __syncthreads(); RESC(alB);
    finishSM(pB0, pB1, alB, l_reg, pa0, pa1, pa2, pa3); SBAR();
    pv_d0(o, vb0 + (int)SHM_V, pa0, pa1, pa2, pa3);
    if (hi == 0) li_l[r32] = l_reg; asm volatile("s_waitcnt lgkmcnt(0)" ::: "memory");
    float rli[16];
#pragma unroll
    for (int r = 0; r < 16; ++r) rli[r] = __builtin_amdgcn_rcpf(li_l[crow(r, hi)]);
    bf16* Ow = Ob + (long)(wid * QBLK) * LDZ;
#pragma unroll
    for (int r = 0; r < 16; ++r) { const int orow = crow(r, hi);
#pragma unroll
        for (int d0 = 0; d0 < 4; d0 += 2) { const unsigned w = cvtpk(o[d0][r] * rli[r], o[d0 + 1][r] * rli[r]);
            if (!dry) { Ow[(long)orow * LDZ + d0 * 32 + r32] = (bf16)(w & 0xffffu); Ow[(long)orow * LDZ + (d0 + 1) * 32 + r32] = (bf16)(w >> 16); } else asm volatile("" :: "v"(w)); } }
    __syncthreads();
#undef KROW
#undef SLOAD
#undef SWRITE
#undef SWAIT
#undef RESC
#undef MASK
}
#undef KSWZ
#undef SBAR
}

constexpr int DM = 2048, NBATCH = 8, SEQ = 4096, CTXL = 256, SA = 4352, TOK = NBATCH * SA, NPAN = TOK / 256, DFF = 5632;
constexpr int NZ = 4864;
constexpr int ZC_POOL = 0, ZC_RWKV = 512, ZC_WIN = 2688, ZC_DENSE = 3712, ZC_PAD = 4736;
constexpr int INW = 12928;
constexpr int NMOD = 9 * DM;
constexpr float LN_EPS = 1e-6f, RMS_EPS = 1e-6f, GN_EPS = 64e-5f;
constexpr float DN_ALPHA = 1.4142135623730951f;

constexpr size_t MiB = 1u << 20;
constexpr size_t WS_CTL = 0, CTL_ZERO_BYTES = 64 * 1024;
constexpr size_t WS_ROPE = 1 * MiB;
constexpr size_t WS_MOD = 2 * MiB;
constexpr size_t WS_STATS = 3584 * 1024;
constexpr size_t WS_IDLN = 3904 * 1024;
constexpr size_t WS_WB = 4 * MiB;
constexpr size_t WS_X = 76 * MiB;
constexpr size_t WS_BON = (76 + 136) * MiB;
constexpr size_t WS_WB2 = (76 + 140) * MiB;
constexpr size_t WS_H = 348 * MiB;
constexpr size_t WS_R = 484 * MiB;
constexpr size_t PLANE = (size_t)TOK * 512 * 2;
constexpr size_t R_MID = 0;
constexpr size_t R_MODP = 0;
constexpr size_t R_Z = 0;
constexpr size_t R_POOL = 323 * MiB, R_O0 = R_POOL + PLANE, R_O1 = R_O0 + PLANE, R_RWR = R_O1 + PLANE;
constexpr size_t R_RWK = R_RWR + PLANE, R_RWV = R_RWK + PLANE, R_RWKK = R_RWV + PLANE, R_RWA0 = R_RWKK + PLANE, R_RWA1 = R_RWA0 + PLANE, R_RWG = R_RWA1 + PLANE;
constexpr size_t R_RWW0 = R_RWG + PLANE, R_RWW1 = R_RWW0 + 2 * PLANE;
constexpr size_t R_UBUF = R_RWW0, R_ACC = R_RWK;
constexpr size_t R_END = R_RWW1 + 2 * PLANE;
constexpr size_t WS_END = WS_R + R_END;
static_assert(R_UBUF + 4 * PLANE <= R_END && R_ACC + 4 * PLANE <= R_RWA1 + PLANE && PLANE == 34 * MiB && (size_t)TOK * NZ * 2 <= R_POOL && (size_t)TOK * DFF * 2 <= R_END, "workspace map");
constexpr size_t WB_WI = 0, WB_WO = (size_t)2 * DFF * DM * 2;
constexpr size_t WB_WIN = 0, WB_WG = (size_t)NZ * DM * 2, WB_WUP = WB_WG + (size_t)8192 * DM * 2, WB_WOUT = WB_WUP + (size_t)4 * DM * 512 * 2;
constexpr size_t WB_POOLW = WB_WOUT + (size_t)DM * DM * 2, WB_W2T = WB_POOLW + 4 * 128 * 128 * 2, WB_A2T = WB_W2T + 2 * 512 * 96 * 2, WB_G2T = WB_A2T + 2 * 512 * 96 * 2, WB_MIX_END = WB_G2T + 512 * 256 * 2;
static_assert(WB_MIX_END <= 72 * MiB && WB_WO + (size_t)DM * DFF * 2 <= 72 * MiB, "weight buffer");

constexpr int RING_BYTES = 131072;
constexpr int LDSCTL_OFF = RING_BYTES, MISC_OFF = LDSCTL_OFF + 320;
constexpr int LDS_BYTES = 147456;
constexpr int NWAVES = 8, NTHR = 512;

#define GAS __attribute__((address_space(1)))
#define LAS __attribute__((address_space(3)))
typedef unsigned short bf16;
typedef unsigned v4u __attribute__((ext_vector_type(4)));
typedef unsigned v2u __attribute__((ext_vector_type(2)));
typedef float f32x4 __attribute__((ext_vector_type(4)));
typedef float f32x16 __attribute__((ext_vector_type(16)));
typedef short bf16x8 __attribute__((ext_vector_type(8)));
#define LDS_WAIT() asm volatile("s_waitcnt lgkmcnt(0)" ::: "memory")

typedef float f32x2_t_ __attribute__((ext_vector_type(2))); typedef __bf16 bf16x2_t_ __attribute__((ext_vector_type(2)));
__device__ __forceinline__ unsigned pk2(float lo, float hi) { const f32x2_t_ v = {lo, hi}; const bf16x2_t_ b = __builtin_convertvector(v, bf16x2_t_); return __builtin_bit_cast(unsigned, b); }
__device__ __forceinline__ unsigned f2bf(float f) { return pk2(f, f) & 0xffffu; }
__device__ __forceinline__ float bflo(unsigned w) { return __uint_as_float(w << 16); }
__device__ __forceinline__ float bfhi(unsigned w) { return __uint_as_float(w & 0xffff0000u); }
__device__ __forceinline__ void unpack8(const v4u w, float (&f)[8]) { f[0] = bflo(w.x); f[1] = bfhi(w.x); f[2] = bflo(w.y); f[3] = bfhi(w.y); f[4] = bflo(w.z); f[5] = bfhi(w.z); f[6] = bflo(w.w); f[7] = bfhi(w.w); }
__device__ __forceinline__ v4u pack8(const float (&f)[8]) { v4u w; w.x = pk2(f[0], f[1]); w.y = pk2(f[2], f[3]); w.z = pk2(f[4], f[5]); w.w = pk2(f[6], f[7]); return w; }
__device__ __forceinline__ float sigmoidf_(float x) { return __builtin_amdgcn_rcpf(1.0f + __expf(-x)); }

#define XB_TMO      128
#define XB_XCNT(j)  (256  + 64 * (j))
#define XB_XSUB(j)  (1280 + 64 * (j))
#define XB_XGEN(j)  (2304 + 64 * (j))
#define XB_TOP      3328
#define XB_TOPGEN   3392
#define XCD_BAR_WORDS 3456
#define XB_SPIN_CAP (1u << 22)

__device__ __forceinline__ unsigned xb_ld(unsigned* p)              { return __hip_atomic_load(p, __ATOMIC_RELAXED, __HIP_MEMORY_SCOPE_AGENT); }
__device__ __forceinline__ unsigned xb_add(unsigned* p, unsigned v) { return __hip_atomic_fetch_add(p, v, __ATOMIC_RELAXED, __HIP_MEMORY_SCOPE_AGENT); }
__device__ __forceinline__ unsigned xb_xcc_id() { return (unsigned)__builtin_amdgcn_s_getreg((3 << 11) | 20) & 0xFu; }
#define XB_SPIN(cond, bar) do { unsigned _sp = 0; while (cond) { __builtin_amdgcn_s_sleep(1); \
    if ((++_sp & 255u) == 0u) { if (xb_ld(&(bar)[XB_TMO])) break; if (_sp > XB_SPIN_CAP) { atomicAdd(&(bar)[XB_TMO], 1u); break; } } } } while (0)

struct XcdBarrier {
    unsigned* bar; unsigned x;
    volatile LAS unsigned* st;
};
__device__ __forceinline__ XcdBarrier xcd_barrier_post(unsigned* bar, volatile LAS unsigned* st) {
    XcdBarrier b; b.bar = bar; b.x = xb_xcc_id(); b.st = st;
    if (threadIdx.x == 0) (void)xb_add(&bar[XB_XCNT(b.x)], 1u);
    return b;
}
__device__ __forceinline__ void xcd_barrier_complete(unsigned* bar, unsigned x, unsigned& nloc, unsigned& nx) {
    const unsigned G = gridDim.x * gridDim.y * gridDim.z;
    unsigned sum, cnt, mine, sp = 0u;
    for (;;) {
        sum = 0u; cnt = 0u; mine = 0u;
#pragma unroll
        for (unsigned j = 0; j < 16; ++j) { const unsigned c = xb_ld(&bar[XB_XCNT(j)]); sum += c; cnt += (c > 0u) ? 1u : 0u; mine = (j == x) ? c : mine; }
        if (sum == G) break;
        __builtin_amdgcn_s_sleep(1);
        if ((++sp & 255u) == 0u) { if (xb_ld(&bar[XB_TMO])) break; if (sp > XB_SPIN_CAP) { atomicAdd(&bar[XB_TMO], 1u); break; } }
    }
    nloc = mine > 0u ? mine : 1u; nx = cnt > 0u ? cnt : 1u;
}
__device__ __forceinline__ void xcd_barrier(const XcdBarrier& b) {
    asm volatile("s_waitcnt vmcnt(0)" ::: "memory");
    __syncthreads();
    if (threadIdx.x == 0) {
        unsigned* bar = b.bar;
        __builtin_amdgcn_s_waitcnt(0);
        unsigned nloc = b.st[0], nx = b.st[1];
        if (nloc == 0u) { xcd_barrier_complete(bar, b.x, nloc, nx); b.st[0] = nloc; b.st[1] = nx; }
        const unsigned old = xb_add(&bar[XB_XSUB(b.x)], 1u);
        const unsigned gen = old / nloc;
        if (old + 1u == (gen + 1u) * nloc) {
            __builtin_amdgcn_fence(__ATOMIC_RELEASE, "agent");
            asm volatile("s_waitcnt vmcnt(0)" ::: "memory");
            const unsigned og = xb_add(&bar[XB_TOP], 1u);
            const unsigned tg = og / nx;
            if (og + 1u == (tg + 1u) * nx) xb_add(&bar[XB_TOPGEN], 1u);
            else XB_SPIN(xb_ld(&bar[XB_TOPGEN]) == tg, bar);
            __builtin_amdgcn_fence(__ATOMIC_ACQUIRE, "agent");
            xb_add(&bar[XB_XGEN(b.x)], 1u);
            asm volatile("s_waitcnt vmcnt(0)" ::: "memory");
        } else {
            XB_SPIN(xb_ld(&bar[XB_XGEN(b.x)]) == gen, bar);
            __builtin_amdgcn_fence(__ATOMIC_ACQUIRE, "agent");
            asm volatile("s_waitcnt vmcnt(0)" ::: "memory");
        }
    }
    __syncthreads();
}

struct Args {
    const float* in[32];
    float* out; unsigned char* ws;
};
enum { I_X = 0, I_C, I_CTX, I_CCTX, I_WMOD, I_BMOD, I_LNG, I_LNB, I_F1WI, I_F1WO, I_F2WI, I_F2WO, I_WIN, I_BGATE, I_POOLW, I_POOLS, I_MU, I_W0, I_W2, I_A0, I_A2, I_G2,
       I_KK, I_KA, I_RK, I_GNG, I_GNB, I_SINK, I_QN, I_KN, I_WUP, I_WOUT };

struct Frame {
    unsigned char* lds;
    int tid, lane, wave, G, bid;
};

__device__ __forceinline__ float dpp_xor1(float v) { return __builtin_bit_cast(float, __builtin_amdgcn_update_dpp(0, __builtin_bit_cast(int, v), 0xB1, 0xF, 0xF, true)); }
__device__ __forceinline__ float dpp_xor2(float v) { return __builtin_bit_cast(float, __builtin_amdgcn_update_dpp(0, __builtin_bit_cast(int, v), 0x4E, 0xF, 0xF, true)); }
__device__ __forceinline__ float dpp_hmir(float v) { return __builtin_bit_cast(float, __builtin_amdgcn_update_dpp(0, __builtin_bit_cast(int, v), 0x141, 0xF, 0xF, true)); }
__device__ __forceinline__ float dpp_mir(float v)  { return __builtin_bit_cast(float, __builtin_amdgcn_update_dpp(0, __builtin_bit_cast(int, v), 0x140, 0xF, 0xF, true)); }
__device__ __forceinline__ float row16_sum(float v) { v += dpp_xor1(v); v += dpp_xor2(v); v += dpp_hmir(v); v += dpp_mir(v); return v; }

__device__ __forceinline__ float wave_sum(float v) {
    v = row16_sum(v);
    const float a = __builtin_bit_cast(float, __builtin_amdgcn_readlane(__builtin_bit_cast(int, v), 0)), b = __builtin_bit_cast(float, __builtin_amdgcn_readlane(__builtin_bit_cast(int, v), 16));
    const float c = __builtin_bit_cast(float, __builtin_amdgcn_readlane(__builtin_bit_cast(int, v), 32)), d = __builtin_bit_cast(float, __builtin_amdgcn_readlane(__builtin_bit_cast(int, v), 48));
    return (a + b) + (c + d);
}

__device__ __forceinline__ void transpose_item(const float* W, int K, int N, bf16* WT, int k0, int n0, int drow0, float* scr, int lane) {
    const int kr = lane >> 3, n4 = (lane & 7) * 4;
    f32x4 v[8];
#pragma unroll
    for (int i = 0; i < 8; ++i) v[i] = *(const f32x4*)(W + (size_t)(k0 + 8 * i + kr) * N + n0 + n4);
#pragma unroll
    for (int i = 0; i < 8; ++i) *(f32x4*)(scr + (8 * i + kr) * 32 + (n4 ^ (4 * i))) = v[i];
    LDS_WAIT(); asm volatile("" ::: "memory");
    const int c = lane & 7;
#pragma unroll
    for (int j = 0; j < 4; ++j) { const int n = (lane >> 3) + 8 * j; const float* s = scr + (8 * c) * 32 + (n ^ (4 * c));
        v4u o; o.x = pk2(s[0 * 32], s[1 * 32]); o.y = pk2(s[2 * 32], s[3 * 32]); o.z = pk2(s[4 * 32], s[5 * 32]); o.w = pk2(s[6 * 32], s[7 * 32]);
        *(v4u*)(WT + (size_t)(drow0 + n) * K + k0 + 8 * c) = o; }
    LDS_WAIT(); asm volatile("" ::: "memory");
}
__device__ __forceinline__ void convert_ffn(const Frame& F, const float* wi, const float* wo, unsigned char* wb, int wg_index, int wg_count) {
    float* scr = (float*)(F.lds + F.wave * 8448);
    const int gw = wg_index * NWAVES + F.wave, NGW = wg_count * NWAVES;
    constexpr int I_WI = (DM / 64) * (2 * DFF / 32), I_WO = (DFF / 64) * (DM / 32);
    bf16* WI = (bf16*)(wb + WB_WI); bf16* WO = (bf16*)(wb + WB_WO);
    for (int it = gw; it < I_WI + I_WO; it += NGW) {
        if (it < I_WI) { const int nblk = 2 * DFF / 32, kb = it / nblk, nb = it % nblk, n0 = nb * 32;
            const int j = n0 < DFF ? n0 : n0 - DFF, drow = 256 * (j >> 7) + (j & 127) + (n0 < DFF ? 0 : 128);
            transpose_item(wi, DM, 2 * DFF, WI, kb * 64, n0, drow, scr, F.lane); }
        else { const int r = it - I_WI, nblk = DM / 32, kb = r / nblk, nb = r % nblk;
            transpose_item(wo, DFF, DM, WO, kb * 64, nb * 32, nb * 32, scr, F.lane); }
    }
}
__device__ __forceinline__ void convert_mix(const Frame& F, const Args& A, int l, unsigned char* wb, const int late, const int widx, const int nwork) {
    float* scr = (float*)(F.lds + F.wave * 8448);
    const int gw = widx * NWAVES + F.wave, NGW = nwork * NWAVES;
    constexpr int NB_E = ZC_PAD / 32, NB_G = (INW - ZC_PAD) / 32, I_INE = (DM / 64) * NB_E, I_G = (DM / 64) * NB_G, I_UP = 4 * (512 / 64) * (DM / 32), I_OUT = (DM / 64) * (DM / 32);
    const float* w_in = A.in[I_WIN] + (size_t)l * DM * INW; const float* w_up = A.in[I_WUP] + (size_t)l * 4 * 512 * DM; const float* w_out = A.in[I_WOUT] + (size_t)l * DM * DM;
    bf16* WIN = (bf16*)(wb + WB_WIN); bf16* WG = (bf16*)(wb + WB_WG); bf16* WUP = (bf16*)(wb + WB_WUP); bf16* WOUT = (bf16*)(wb + WB_WOUT);
    if (late) {
        for (int it = gw; it < I_G + I_UP + I_OUT; it += NGW) {
            if (it < I_G) { const int kb = it / NB_G, nb = it % NB_G, n0 = ZC_PAD + nb * 32;
                transpose_item(w_in, DM, INW, WG, kb * 64, n0, n0 - ZC_PAD, scr, F.lane); }
            else if (it < I_G + I_UP) { const int r = it - I_G, per = (512 / 64) * (DM / 32), br = r / per, q = r % per, nblk = DM / 32, kb = q / nblk, nb = q % nblk;
                transpose_item(w_up + (size_t)br * 512 * DM, 512, DM, WUP + (size_t)br * DM * 512, kb * 64, nb * 32, nb * 32, scr, F.lane); }
            else { const int r = it - I_G - I_UP, nblk = DM / 32, kb = r / nblk, nb = r % nblk;
                transpose_item(w_out, DM, DM, WOUT, kb * 64, nb * 32, nb * 32, scr, F.lane); }
        }
        return;
    }
    for (int it = gw; it < I_INE; it += NGW) { const int kb = it / NB_E, nb = it % NB_E, n0 = nb * 32;
        transpose_item(w_in, DM, INW, WIN, kb * 64, n0, n0, scr, F.lane); }
    const int gt = F.bid * NTHR + F.tid, NGT = F.G * NTHR;
    { unsigned z_ = 0u; asm volatile("" : "+v"(z_));
      for (int i = gt; i < 128 * DM / 8; i += NGT) *(v4u*)(WIN + (size_t)ZC_PAD * DM + (size_t)i * 8) = (v4u){z_, z_, z_, z_}; }
    bf16* PW = (bf16*)(wb + WB_POOLW); bf16* W2T = (bf16*)(wb + WB_W2T); bf16* A2T = (bf16*)(wb + WB_A2T); bf16* G2T = (bf16*)(wb + WB_G2T);
    const float* pool_w = A.in[I_POOLW] + (size_t)l * 4 * 128 * 128; const float* w2 = A.in[I_W2] + (size_t)l * 2 * 96 * 512; const float* a2 = A.in[I_A2] + (size_t)l * 2 * 96 * 512; const float* g2 = A.in[I_G2] + (size_t)l * 256 * 512;
    for (int i = gt; i < 4 * 128 * 128; i += NGT) { const int g = i >> 14, d = (i >> 7) & 127, c = i & 127; PW[i] = (bf16)f2bf(pool_w[(g * 128 + c) * 128 + d]); }
    for (int i = gt; i < 2 * 512 * 96; i += NGT) { const int dd = i / (512 * 96), r = i % (512 * 96), n = r / 96, k = r % 96;
        W2T[i] = (bf16)f2bf(w2[(dd * 96 + k) * 512 + n]); A2T[i] = (bf16)f2bf(a2[(dd * 96 + k) * 512 + n]); }
    for (int i = gt; i < 512 * 256; i += NGT) { const int n = i >> 8, k = i & 255; G2T[i] = (bf16)f2bf(g2[k * 512 + n]); }
}

__device__ __forceinline__ void mod_partial(const Frame& F, const Args& A, float* modp) {
    float* sc = (float*)F.lds;
    for (int it = F.bid; it < 2 * 16 * 9; it += F.G) {
        const int l = it / 144, r = it % 144, ks = r / 9, nb = r % 9, k0 = ks * 128, n0 = nb * 2048 + F.tid * 4;
        __syncthreads();
        for (int i = F.tid; i < 9 * 128; i += NTHR) { const int bi = i >> 7, k = i & 127; const float cv = bi < 8 ? A.in[I_C][bi * DM + k0 + k] : A.in[I_CCTX][k0 + k]; sc[i] = cv * sigmoidf_(cv); }
        __syncthreads();
        const float* w = A.in[I_WMOD] + ((size_t)l * DM + k0) * NMOD + n0;
        f32x4 acc[9];
#pragma unroll
        for (int b = 0; b < 9; ++b) acc[b] = (f32x4){0.f, 0.f, 0.f, 0.f};
#pragma unroll 4
        for (int k = 0; k < 128; ++k) { const f32x4 wv = *(const f32x4*)(w + (size_t)k * NMOD);
#pragma unroll
            for (int b = 0; b < 9; ++b) acc[b] += wv * sc[b * 128 + k]; }
#pragma unroll
        for (int b = 0; b < 9; ++b) *(f32x4*)(modp + (((size_t)ks * 2 + l) * 9 + b) * NMOD + n0) = acc[b];
    }
    __syncthreads();
}
__device__ __forceinline__ void mod_reduce(const Frame& F, const Args& A, const float* modp, float* mod) {
    const int gt = F.bid * NTHR + F.tid, NGT = F.G * NTHR;
    for (int i = gt; i < 2 * 9 * NMOD / 4; i += NGT) { const int e = i * 4, l = e / (9 * NMOD), n = e % NMOD;
        f32x4 s = *(const f32x4*)(A.in[I_BMOD] + (size_t)l * NMOD + n);
#pragma unroll
        for (int ks = 0; ks < 16; ++ks) s += *(const f32x4*)(modp + (size_t)ks * 2 * 9 * NMOD + e);
        *(f32x4*)(mod + e) = s; }
}
__device__ __forceinline__ void rope_table(const Frame& F, float* tab, float* idln) {
    const int gt = F.bid * NTHR + F.tid;
    if (gt < 2 * DM) idln[gt] = gt < DM ? 1.0f : 0.0f;
    if (gt < 64 * 32) { const int p = gt >> 5, f = gt & 31; const float inv = powf(10000.0f, -(float)f / 32.0f); const float ang = (float)p * inv; tab[2 * gt] = cosf(ang); tab[2 * gt + 1] = sinf(ang); }
}

__device__ __forceinline__ const float* input_row(const Args& A, int row) { const int b = row / SA, s = row - b * SA; return s < CTXL ? A.in[I_CTX] + ((size_t)b * CTXL + s) * DM : A.in[I_X] + ((size_t)b * SEQ + (s - CTXL)) * DM; }
__device__ __forceinline__ void modulate_input(const Frame& F, const Args& A, const float* modl, bf16* H, _Float16* X, float* stats) {
    typedef _Float16 f16x8 __attribute__((ext_vector_type(8))); typedef float f32x8 __attribute__((ext_vector_type(8)));
    int NGW = F.G * NWAVES; asm volatile("" : "+s"(NGW));
    const int gw = F.bid * NWAVES + F.wave, per = (TOK + NGW - 1) / NGW;
    const int i0 = gw * per, i1 = (i0 + per) < TOK ? (i0 + per) : TOK;
    int cur_bi = -1; f32x8 Cv[4], Sv[4], nx[4];
#pragma unroll
    for (int j = 0; j < 4; ++j) { Cv[j] = (f32x8){0.f, 0.f, 0.f, 0.f, 0.f, 0.f, 0.f, 0.f}; Sv[j] = Cv[j]; nx[j] = Cv[j]; }
    if (i0 < i1) { const float* xr = input_row(A, i0);
#pragma unroll
        for (int j = 0; j < 4; ++j) nx[j] = *(const f32x8*)(xr + j * 512 + F.lane * 8); }
#pragma unroll 1
    for (int row = i0; row < i1; ++row) {
        const int b = row / SA, s = row - b * SA, bi = s < CTXL ? 8 : b;
        f32x8 a[4];
#pragma unroll
        for (int j = 0; j < 4; ++j) a[j] = nx[j];
        if (row + 1 < i1) { const float* xr = input_row(A, row + 1);
#pragma unroll
            for (int j = 0; j < 4; ++j) nx[j] = *(const f32x8*)(xr + j * 512 + F.lane * 8); }
        if (bi != cur_bi) { cur_bi = bi; const float* sh = modl + (size_t)bi * NMOD; const float* scl = sh + DM;
#pragma unroll
            for (int j = 0; j < 4; ++j) { const int c = j * 512 + F.lane * 8; Sv[j] = *(const f32x8*)(sh + c); Cv[j] = *(const f32x8*)(scl + c) + 1.0f; } }
        if (F.lane == 0) { stats[2 * (size_t)row] = 0.0f; stats[2 * (size_t)row + 1] = 1.0f; }
#pragma unroll
        for (int j = 0; j < 4; ++j) { const int c = j * 512 + F.lane * 8;
            const f32x8 h = a[j] * Cv[j] + Sv[j];
            v4u w; w.x = pk2(h[0], h[1]); w.y = pk2(h[2], h[3]); w.z = pk2(h[4], h[5]); w.w = pk2(h[6], h[7]);
            *(v4u*)(H + (size_t)row * DM + c) = w;
            *(f16x8*)(X + (size_t)row * DM + c) = __builtin_convertvector(a[j], f16x8); }
    }
}
__device__ __forceinline__ void ln_pass(const Frame& F, const _Float16* X, float* stats, const float* g, const float* bta, const float* modsh  , int kshift, bf16* H, float* out, bool latent_only, const int dry) {
    typedef _Float16 f16x8 __attribute__((ext_vector_type(8))); typedef float f32x8 __attribute__((ext_vector_type(8)));
    int NGW = F.G * NWAVES; asm volatile("" : "+s"(NGW));
    const int gw = F.bid * NWAVES + F.wave;
    const int nrows = latent_only ? NBATCH * SEQ : TOK, per = (nrows + NGW - 1) / NGW;
    int cur_bi = -1; f32x8 Gv[4], Bv[4];
#pragma unroll
    for (int j = 0; j < 4; ++j) { Gv[j] = (f32x8){0.f, 0.f, 0.f, 0.f, 0.f, 0.f, 0.f, 0.f}; Bv[j] = Gv[j]; }
    const int i0 = gw * per, i1 = (i0 + per) < nrows ? (i0 + per) : nrows;
    f16x8 raw[4];
    if (i0 < i1) { int r0 = i0; if (latent_only) { const int b0 = i0 / SEQ; r0 = b0 * SA + CTXL + (i0 - b0 * SEQ); }
#pragma unroll
        for (int j = 0; j < 4; ++j) raw[j] = *(const f16x8*)(X + (size_t)r0 * DM + j * 512 + F.lane * 8); }
#pragma unroll 1
    for (int idx = i0; idx < i1; ++idx) {
        int row, b, s;
        if (latent_only) { b = idx / SEQ; s = CTXL + (idx - b * SEQ); row = b * SA + s; } else { row = idx; b = row / SA; s = row - b * SA; }
        const int bi = s < CTXL ? 8 : b;
        f32x8 v[4]; float sum = 0.f;
#pragma unroll
        for (int j = 0; j < 4; ++j) { v[j] = __builtin_convertvector(raw[j], f32x8);
            sum += ((v[j][0] + v[j][1]) + (v[j][2] + v[j][3])) + ((v[j][4] + v[j][5]) + (v[j][6] + v[j][7])); }
        if (idx + 1 < i1) { int rn = idx + 1; if (latent_only) { const int bn = rn / SEQ; rn = bn * SA + CTXL + (rn - bn * SEQ); }
#pragma unroll
            for (int j = 0; j < 4; ++j) raw[j] = *(const f16x8*)(X + (size_t)rn * DM + j * 512 + F.lane * 8); }
        if (bi != cur_bi) { cur_bi = bi;
            const float* sh = modsh ? modsh + ((size_t)bi * 9 + kshift) * DM : nullptr;
#pragma unroll
            for (int j = 0; j < 4; ++j) { const int c = j * 512 + F.lane * 8;
#pragma unroll
                for (int q = 0; q < 2; ++q) { const f32x4 gg = *(const f32x4*)(g + c + 4 * q), bb = *(const f32x4*)(bta + c + 4 * q); f32x4 G_ = gg, B_ = bb;
                    if (sh) { const f32x4 sc = *(const f32x4*)(sh + DM + c + 4 * q) + 1.0f; G_ = gg * sc; B_ = bb * sc + *(const f32x4*)(sh + c + 4 * q); }
#pragma unroll
                    for (int e = 0; e < 4; ++e) { Gv[j][4 * q + e] = G_[e]; Bv[j][4 * q + e] = B_[e]; } } } }
        const float mean = wave_sum(sum) * (1.0f / DM); float s2 = 0.f;
#pragma unroll
        for (int j = 0; j < 4; ++j) { v[j] = v[j] - mean;
            s2 += ((v[j][0] * v[j][0] + v[j][1] * v[j][1]) + (v[j][2] * v[j][2] + v[j][3] * v[j][3])) + ((v[j][4] * v[j][4] + v[j][5] * v[j][5]) + (v[j][6] * v[j][6] + v[j][7] * v[j][7])); }
        const float rstd = 1.0f / sqrtf(wave_sum(s2) * (1.0f / DM) + LN_EPS);
        if (!dry && F.lane == 0) { stats[2 * (size_t)row] = mean; stats[2 * (size_t)row + 1] = rstd; }
#pragma unroll
        for (int j = 0; j < 4; ++j) { const int c = j * 512 + F.lane * 8;
            const f32x8 y = v[j] * rstd * Gv[j] + Bv[j];
            if (out) { const f32x4 y0 = (f32x4){y[0], y[1], y[2], y[3]}, y1 = (f32x4){y[4], y[5], y[6], y[7]};
                if (dry) asm volatile("" :: "v"(y0), "v"(y1)); else if (s >= CTXL) { float* o = out + ((size_t)b * SEQ + (s - CTXL)) * DM + c; *(f32x4*)o = y0; *(f32x4*)(o + 4) = y1; } }
            if (H) { v4u w; w.x = pk2(y[0], y[1]); w.y = pk2(y[2], y[3]); w.z = pk2(y[4], y[5]); w.w = pk2(y[6], y[7]); if (!dry) *(v4u*)(H + (size_t)row * DM + c) = w; else asm volatile("" :: "v"(w)); } }
    }
}

__device__ __forceinline__ v4u ldz8(const bf16* p) { return *(const v4u*)p; }
__device__ __forceinline__ float group8_sum(float v) { v += dpp_xor1(v); v += dpp_xor2(v); v += dpp_hmir(v); return v; }
__device__ __forceinline__ int crow_(int r, int hi) { return (r & 3) + 8 * (r >> 2) + 4 * hi; }

struct MixPtrs {
    bf16* Z; bf16* POOL; bf16* O0; bf16* O1; bf16* RWR; bf16* RWK; bf16* RWV; bf16* RWKK; bf16* RWA0; bf16* RWA1; bf16* RWG; float* RWW0; float* RWW1;
    float* BON;
};

template <int TT> __device__ __forceinline__ void prep_tile(const Frame& F, const Args& A, int l, const MixPtrs& P, const unsigned char* wb, const float* ropetab, int ti, const int dry, const int parts) {
    constexpr int TPB = SA / TT, TCX = CTXL / TT;
    const int b = ti / TPB, tl = ti - b * TPB; const bool isctx = tl < TCX;
    const int t0 = isctx ? tl * TT : (tl - TCX) * TT, T = isctx ? CTXL : SEQ, segrow0 = b * SA + (isctx ? 0 : CTXL);
    const int r32 = F.lane & 31, hi = F.lane >> 5;
    unsigned char* lds = F.lds;
    constexpr int LWS = 400, LGS = 528, LW_OFF = 0, LA_OFF = TT * LWS, LG_OFF = 2 * TT * LWS;
#ifndef PREP_REP_A
#define PREP_REP_A 1
#endif
    if constexpr (TT == 64) if (parts & 1) for (int prp_ = 0; prp_ < PREP_REP_A; ++prp_) { const int pdry = dry | (prp_ + 1 < PREP_REP_A ? 1 : 0); (void)pdry;
    constexpr int PLS = 1040;
#pragma unroll 1
    for (int k = 0; k < 8; ++k) {
        const int tt = F.wave + 8 * k, ch8 = F.lane, g = ch8 >> 4, half = 1 << g, t = t0 + tt;
        const int lo = (t - half) > 0 ? (t - half) : 0, hi_ = (t + half) < T ? (t + half) : T;
        float acc[8] = {0.f, 0.f, 0.f, 0.f, 0.f, 0.f, 0.f, 0.f};
        const bf16* zc = P.Z + (size_t)segrow0 * NZ + ZC_POOL + ch8 * 8;
        v4u wv[16];
#pragma unroll
        for (int i = 0; i < 16; ++i) { const int tau = t - half + i; const bool ok = (i < 2 * half) && tau >= 0 && tau < T; wv[i] = ok ? ldz8(zc + (size_t)tau * NZ) : (v4u){0u, 0u, 0u, 0u}; }
#pragma unroll
        for (int i = 0; i < 16; ++i) { float f[8]; unpack8(wv[i], f);
#pragma unroll
            for (int j = 0; j < 8; ++j) acc[j] += f[j]; }
        float own[8]; unpack8(ldz8(zc + (size_t)t * NZ), own);
        const float inv = 1.0f / (float)(hi_ - lo);
        float o[8];
#pragma unroll
        for (int j = 0; j < 8; ++j) o[j] = acc[j] * inv - own[j];
        *(v4u*)(lds + tt * PLS + ch8 * 16) = pack8(o);
    }
    __syncthreads();
    {
        const int g = F.wave & 3, mh = F.wave >> 2;
        const bf16* PW = (const bf16*)(wb + WB_POOLW);
        const float* ps = A.in[I_POOLS] + l * 512;
#pragma unroll 1
        for (int nt = 0; nt < 4; ++nt) {
            const int col = g * 128 + nt * 32 + r32;
            const bf16* bt = PW + (size_t)col * 128 + hi * 8; const unsigned char* ap = lds + (mh * 32 + r32) * PLS + (g * 128 + hi * 8) * 2;
            f32x16 acc = {};
            bf16x8 b_[8];
#pragma unroll
            for (int ks = 0; ks < 8; ++ks) b_[ks] = *(const bf16x8*)(bt + ks * 16);
#pragma unroll
            for (int ks = 0; ks < 8; ++ks) { const bf16x8 a_ = *(const bf16x8*)(ap + ks * 32); acc = __builtin_amdgcn_mfma_f32_32x32x16_bf16(a_, b_[ks], acc, 0, 0, 0); }
            const float sc = ps[col]; bf16* OP = P.POOL + (size_t)(segrow0 + t0 + mh * 32 + 4 * hi) * 512 + col;
#pragma unroll
            for (int r = 0; r < 16; ++r) OP[((r & 3) + 8 * (r >> 2)) * 512] = (bf16)f2bf(acc[r] * sc);
        }
    }
    __syncthreads();
    }
#ifndef PREP_REP_B
#define PREP_REP_B 1
#endif
    if (parts & 2) for (int prp_ = 0; prp_ < PREP_REP_B; ++prp_) { const int pdry = dry | (prp_ + 1 < PREP_REP_B ? 1 : 0); (void)pdry;
    {
        const float* mu = A.in[I_MU] + l * 2176; const float* kkw = A.in[I_KK] + l * 512;
#define PREP_EMIT(tt_, c_, zs_) do { const size_t row = (size_t)(segrow0 + t0 + (tt_)); \
            if ((c_) < 512) *(v4u*)(P.RWR + row * 512 + (c_)) = pack8(zs_); \
            else if ((c_) < 1024) { float kkv[8]; float ss = 0.f; _Pragma("unroll") for (int e = 0; e < 8; ++e) { kkv[e] = zs_[e] * kw[e]; ss += kkv[e] * kkv[e]; } \
                ss = group8_sum(ss); *(v4u*)(P.RWK + row * 512 + (c_) - 512) = pack8(zs_); const float rn = 1.0f / sqrtf(ss + 1e-12f); \
                _Pragma("unroll") for (int e = 0; e < 8; ++e) kkv[e] *= rn; \
                *(v4u*)(P.RWKK + row * 512 + (c_) - 512) = pack8(kkv); } \
            else if ((c_) < 1536) *(v4u*)(P.RWV + row * 512 + (c_) - 1024) = pack8(zs_); \
            else if ((c_) < 1728) { float o[8]; _Pragma("unroll") for (int e = 0; e < 8; ++e) o[e] = 1.0f - 2.0f * __builtin_amdgcn_rcpf(1.0f + __expf(2.0f * zs_[e])); \
                *(v4u*)(lds + LW_OFF + (tt_) * LWS + ((c_) - 1536) * 2) = pack8(o); } \
            else if ((c_) < 1920) *(v4u*)(lds + LA_OFF + (tt_) * LWS + ((c_) - 1728) * 2) = pack8(zs_); \
            else { float o[8]; _Pragma("unroll") for (int e = 0; e < 8; ++e) o[e] = sigmoidf_(zs_[e]); \
                *(v4u*)(lds + LG_OFF + (tt_) * LGS + ((c_) - 1920) * 2) = pack8(o); } } while (0)
        {
            constexpr int HT = TT / 2;
            const int cg = F.tid & 255, tb = (F.tid >> 8) * HT, c = cg * 8, tg = t0 + tb;
            float m8[8], kw[8];
            { const f32x4 m0 = *(const f32x4*)(mu + c), m1 = *(const f32x4*)(mu + c + 4);
#pragma unroll
              for (int e = 0; e < 8; ++e) { m8[e] = e < 4 ? m0[e] : m1[e - 4]; kw[e] = 0.f; } }
            if (c >= 512 && c < 1024) { const f32x4 k0 = *(const f32x4*)(kkw + c - 512), k1 = *(const f32x4*)(kkw + c - 512 + 4);
#pragma unroll
                for (int e = 0; e < 8; ++e) kw[e] = e < 4 ? k0[e] : k1[e - 4]; }
            const bf16* zp = P.Z + (size_t)(segrow0 + tg) * NZ + ZC_RWKV + c;
            float prv[8], cur[8];
            if (tg > 0) unpack8(ldz8(zp - NZ), prv); else {
#pragma unroll
                for (int e = 0; e < 8; ++e) prv[e] = 0.f; }
            unpack8(ldz8(zp), cur);
#pragma unroll 1
            for (int i = 0; i < HT; i += 4) {
                v4u raw[4];
#pragma unroll
                for (int j = 0; j < 4; ++j) { const bool ok = (tg + i + j + 1) < T; raw[j] = ok ? ldz8(zp + (size_t)(i + j + 1) * NZ) : (v4u){0u, 0u, 0u, 0u}; }
#pragma unroll
                for (int j = 0; j < 4; ++j) { float nxt[8], zs[8]; unpack8(raw[j], nxt);
#pragma unroll
                    for (int e = 0; e < 8; ++e) zs[e] = cur[e] + (0.5f * (prv[e] + nxt[e]) - cur[e]) * m8[e];
                    PREP_EMIT(tb + i + j, c, zs);
#pragma unroll
                    for (int e = 0; e < 8; ++e) { prv[e] = cur[e]; cur[e] = nxt[e]; } }
            }
        }
#pragma unroll 1
        for (int it = F.tid; it < TT * 16; it += NTHR) {
            const int tt = it >> 4, c = 2048 + (it & 15) * 8, t = t0 + tt;
            const bf16* zp = P.Z + (size_t)(segrow0 + t) * NZ + ZC_RWKV + c;
            float cur[8], prv[8], nxt[8], kw[8];
            unpack8(ldz8(zp), cur);
            if (t > 0) unpack8(ldz8(zp - NZ), prv); else {
#pragma unroll
                for (int e = 0; e < 8; ++e) prv[e] = 0.f; }
            if (t < T - 1) unpack8(ldz8(zp + NZ), nxt); else {
#pragma unroll
                for (int e = 0; e < 8; ++e) nxt[e] = 0.f; }
            const f32x4 m0 = *(const f32x4*)(mu + c), m1 = *(const f32x4*)(mu + c + 4);
            float zs[8];
#pragma unroll
            for (int e = 0; e < 8; ++e) { const float m = e < 4 ? m0[e] : m1[e - 4]; zs[e] = cur[e] + (0.5f * (prv[e] + nxt[e]) - cur[e]) * m; kw[e] = 0.f; }
            PREP_EMIT(tt, c, zs);
        }
#undef PREP_EMIT
    }
    __syncthreads();
    }
#ifndef PREP_REP_M
#define PREP_REP_M 1
#endif
    if (parts & 2) for (int prp_ = 0; prp_ < PREP_REP_M; ++prp_) { const int pdry = dry | (prp_ + 1 < PREP_REP_M ? 1 : 0); (void)pdry;
    {
        const bf16* W2T = (const bf16*)(wb + WB_W2T); const bf16* A2T = (const bf16*)(wb + WB_A2T); const bf16* G2T = (const bf16*)(wb + WB_G2T);
#pragma unroll 1
        for (int q = 0; q < 5 * (TT / 32); ++q) {
            const int job = q / (TT / 32), mt = (TT == 64) ? (q & 1) : 0, d = job & 1;
            const int col = F.wave * 64 + r32;
            const int loff = job < 2 ? LW_OFF : job < 4 ? LA_OFF : LG_OFF, lstr = job < 4 ? LWS : LGS, koff = job < 4 ? d * 96 : 0, kfull = job < 4 ? 96 : 256;
            const bf16* bt = (job < 2 ? W2T + (size_t)d * 512 * 96 : job < 4 ? A2T + (size_t)d * 512 * 96 : G2T) + (size_t)col * kfull + hi * 8;
            const unsigned char* ap = lds + loff + (mt * 32 + r32) * lstr + (koff + hi * 8) * 2;
            f32x16 acc0 = {}, acc1 = {};
            if (job < 4) { bf16x8 b0_[6], b1_[6];
#pragma unroll
                for (int ks = 0; ks < 6; ++ks) { b0_[ks] = *(const bf16x8*)(bt + ks * 16); b1_[ks] = *(const bf16x8*)(bt + 32 * 96 + ks * 16); }
#pragma unroll
                for (int ks = 0; ks < 6; ++ks) { const bf16x8 a_ = *(const bf16x8*)(ap + ks * 32); acc0 = __builtin_amdgcn_mfma_f32_32x32x16_bf16(a_, b0_[ks], acc0, 0, 0, 0); acc1 = __builtin_amdgcn_mfma_f32_32x32x16_bf16(a_, b1_[ks], acc1, 0, 0, 0); } }
            else { bf16x8 b0_[16], b1_[16];
#pragma unroll
                for (int ks = 0; ks < 16; ++ks) { b0_[ks] = *(const bf16x8*)(bt + ks * 16); b1_[ks] = *(const bf16x8*)(bt + 32 * 256 + ks * 16); }
#pragma unroll
                for (int ks = 0; ks < 16; ++ks) { const bf16x8 a_ = *(const bf16x8*)(ap + ks * 32); acc0 = __builtin_amdgcn_mfma_f32_32x32x16_bf16(a_, b0_[ks], acc0, 0, 0, 0); acc1 = __builtin_amdgcn_mfma_f32_32x32x16_bf16(a_, b1_[ks], acc1, 0, 0, 0); } }
            const size_t rowb = (size_t)(segrow0 + t0 + mt * 32 + 4 * hi) * 512 + col;
            if (job < 2) { float* WP = (d ? P.RWW1 : P.RWW0) + rowb; const float* w0 = A.in[I_W0] + (l * 2 + d) * 512 + col; const float w0a = w0[0], w0b = w0[32];
#pragma unroll
                for (int r = 0; r < 16; ++r) { const int ro = ((r & 3) + 8 * (r >> 2)) * 512; WP[ro] = __expf(-0.6065306597126334f * sigmoidf_(acc0[r] + w0a)); WP[ro + 32] = __expf(-0.6065306597126334f * sigmoidf_(acc1[r] + w0b)); } }
            else if (job < 4) { bf16* AP = (d ? P.RWA1 : P.RWA0) + rowb; const float* a0 = A.in[I_A0] + (l * 2 + d) * 512 + col; const float a0a = a0[0], a0b = a0[32];
#pragma unroll
                for (int r = 0; r < 16; ++r) { const int ro = ((r & 3) + 8 * (r >> 2)) * 512; AP[ro] = (bf16)f2bf(sigmoidf_(acc0[r] + a0a)); AP[ro + 32] = (bf16)f2bf(sigmoidf_(acc1[r] + a0b)); } }
            else { bf16* GP = P.RWG + rowb;
#pragma unroll
                for (int r = 0; r < 16; ++r) { const int ro = ((r & 3) + 8 * (r >> 2)) * 512; GP[ro] = (bf16)f2bf(acc0[r]); GP[ro + 32] = (bf16)f2bf(acc1[r]); } }
        }
    }
    }
#ifndef PREP_REP_C
#define PREP_REP_C 1
#endif
    if (parts & 2) for (int prp_ = 0; prp_ < PREP_REP_C; ++prp_) { const int pdry = dry | (prp_ + 1 < PREP_REP_C ? 1 : 0); (void)pdry;
    {
        const float* qn = A.in[I_QN] + l * 128; const float* kn = A.in[I_KN] + l * 128;
#pragma unroll 3
        for (int it = F.tid; it < TT * 96; it += NTHR) {
            const int sub = it & 7, hd = (it >> 3) % 12, tt = it / 96, a = sub >> 2, fc = sub & 3, t = t0 + tt;
            const bool dense = hd >= 6;
            bf16* p = P.Z + (size_t)(segrow0 + t) * NZ + (dense ? ZC_DENSE + (hd - 6) * 128 : ZC_WIN + hd * 128) + a * 64 + fc * 8;
            float x1[8], x2[8]; unpack8(ldz8(p), x1); unpack8(ldz8(p + 32), x2);
            float ss = 0.f;
            if (dense) {
#pragma unroll
                for (int j = 0; j < 8; ++j) ss += x1[j] * x1[j] + x2[j] * x2[j]; }
            ss = group8_sum(ss);
            if (dense) { const float rinv = 1.0f / sqrtf(ss * (1.0f / 128.0f) + RMS_EPS); const float* gn = (hd < 10 ? qn : kn) + a * 64 + fc * 8;
#pragma unroll
                for (int j = 0; j < 8; ++j) { x1[j] *= rinv * gn[j]; x2[j] *= rinv * gn[32 + j]; } }
            if (!isctx) { const int pos = a == 0 ? (t >> 6) : (t & 63); const float* cs = ropetab + (pos * 32 + fc * 8) * 2;
#pragma unroll
                for (int j = 0; j < 8; ++j) { const float c_ = cs[2 * j], s_ = cs[2 * j + 1]; const float y1 = x1[j] * c_ - x2[j] * s_, y2 = x2[j] * c_ + x1[j] * s_; x1[j] = y1; x2[j] = y2; } }
            if ((dense || !isctx) && !pdry) { *(v4u*)p = pack8(x1); *(v4u*)(p + 32) = pack8(x2); }
        }
    }
    }
    __syncthreads();
}

__device__ __forceinline__ void scan_unit(const Frame& F, const Args& A, int l, const MixPtrs& P, int u) {
    const int h = u & 7, b = (u >> 3) & 7, d = u >> 6;
    constexpr int STEP_F = 384, CH = 32, BUF_F = CH * STEP_F;
    float* lbuf = (float*)F.lds; float* part = lbuf + 2 * BUF_F + F.wave * 1024;
    const int ls = F.tid >> 4, j4 = (F.tid & 15) * 4, col = h * 64 + j4;
    const bf16* pa = d ? P.RWA1 : P.RWA0; const float* pw = d ? P.RWW1 : P.RWW0; bf16* po = d ? P.O1 : P.O0;
    const f32x4 ka4 = *(const f32x4*)(A.in[I_KA] + l * 512 + col);
    const size_t brow = (size_t)b * SA;
    struct { v2u r, k, v, kk, a; f32x4 w; } st;
#define SROW(n) (brow + (size_t)(d == 0 ? (n) : ((n) < CTXL ? (CTXL - 1 - (n)) : (SA + CTXL - 1 - (n)))))
#define SC_LOAD(c) do { const size_t o_ = SROW((c) * CH + ls) * 512 + col; st.r = *(const v2u*)(P.RWR + o_); st.k = *(const v2u*)(P.RWK + o_); st.v = *(const v2u*)(P.RWV + o_); \
        st.kk = *(const v2u*)(P.RWKK + o_); st.a = *(const v2u*)(pa + o_); st.w = *(const f32x4*)(pw + o_); } while (0)
#define SC_WRITE(bufi, chunk) do { float* q_ = lbuf + (bufi) * BUF_F + ls * STEP_F; \
        const f32x4 kk_ = (f32x4){bflo(st.kk.x), bfhi(st.kk.x), bflo(st.kk.y), bfhi(st.kk.y)}, a_ = (f32x4){bflo(st.a.x), bfhi(st.a.x), bflo(st.a.y), bfhi(st.a.y)}; \
        const f32x4 k_ = (f32x4){bflo(st.k.x), bfhi(st.k.x), bflo(st.k.y), bfhi(st.k.y)}, r_ = (f32x4){bflo(st.r.x), bfhi(st.r.x), bflo(st.r.y), bfhi(st.r.y)}; \
        const f32x4 krep_ = k_ * ((a_ - 1.0f) * ka4 + 1.0f); \
        *(f32x4*)(q_ + j4) = kk_; *(f32x4*)(q_ + 64 + j4) = st.w; *(f32x4*)(q_ + 128 + j4) = kk_ * a_; *(f32x4*)(q_ + 192 + j4) = krep_; *(f32x4*)(q_ + 256 + j4) = r_; \
        *(f32x4*)(q_ + 320 + j4) = (f32x4){bflo(st.v.x), bfhi(st.v.x), bflo(st.v.y), bfhi(st.v.y)}; (void)(chunk); } while (0)
    typedef float f32x2 __attribute__((ext_vector_type(2)));
    const int r0 = F.wave * 8 + (F.lane >> 4) * 2, jg = F.lane & 15;
    float* pwa = part + ((F.lane >> 4) * 2) * 16 + jg;
    const float* prd = part + F.lane * 16; const int psl = F.lane >> 3, prow = F.wave * 8 + (F.lane & 7);
    const int prot = (F.lane >> 2) & 3, pr0 = 4 * prot, pr1 = 4 * ((prot + 1) & 3), pr2 = 4 * ((prot + 2) & 3), pr3 = 4 * ((prot + 3) & 3);
    f32x2 Sa0 = (f32x2){0.f, 0.f}, Sa1 = Sa0, Sb0 = Sa0, Sb1 = Sa0;
    __syncthreads();
    SC_LOAD(0); SC_WRITE(0, 0);
    __syncthreads();
    constexpr int NCH = SA / CH;
#pragma unroll 1
    for (int c = 0; c < NCH; ++c) {
        if (c + 1 < NCH) SC_LOAD(c + 1);
        const float* cb = lbuf + (c & 1) * BUF_F;
        const float* q0_ = cb + jg * 4; const float* v0_ = cb + 320 + r0;
#define SC_LD(KK, W, BB, KR, RR, VV, st_) do { const float* q_ = q0_ + (st_) * STEP_F; KK = *(const f32x4*)(q_); W = *(const f32x4*)(q_ + 64); BB = *(const f32x4*)(q_ + 128); KR = *(const f32x4*)(q_ + 192); RR = *(const f32x4*)(q_ + 256); VV = *(const f32x2*)(v0_ + (st_) * STEP_F); } while (0)
        f32x4 akk, aw, abb, akr, arr, bkk, bw, bbb, bkr, brr; f32x2 avv, bvv;
        SC_LD(akk, aw, abb, akr, arr, avv, 0); SC_LD(bkk, bw, bbb, bkr, brr, bvv, 1);
#pragma unroll
        for (int s = 0; s < CH; ++s) {
            const f32x4 kk = akk, w = aw, bb = abb, kr = akr, rr = arr; const f32x2 vv = avv;
            akk = bkk; aw = bw; abb = bbb; akr = bkr; arr = brr; avv = bvv;
            if (s + 2 < CH) SC_LD(bkk, bw, bbb, bkr, brr, bvv, s + 2);
            __builtin_amdgcn_sched_barrier(0);
#define LO2(x) __builtin_shufflevector(x, x, 0, 1)
#define HI2(x) __builtin_shufflevector(x, x, 2, 3)
            const f32x2 kk0 = LO2(kk), kk1 = HI2(kk), w0 = LO2(w), w1 = HI2(w), bb0 = LO2(bb), bb1 = HI2(bb), kr0 = LO2(kr), kr1 = HI2(kr), rr0 = LO2(rr), rr1 = HI2(rr);
            const f32x2 ta = Sa1 * kk1 + Sa0 * kk0, tb = Sb1 * kk1 + Sb0 * kk0;
            float ska = ta.x + ta.y, skb = tb.x + tb.y;
            ska += dpp_xor1(ska); skb += dpp_xor1(skb); ska += dpp_xor2(ska); skb += dpp_xor2(skb); ska += dpp_hmir(ska); skb += dpp_hmir(skb); ska += dpp_mir(ska); skb += dpp_mir(skb);
            const f32x2 pa0 = Sa0 * w0 + kr0 * vv.x, pa1 = Sa1 * w1 + kr1 * vv.x, pb0 = Sb0 * w0 + kr0 * vv.y, pb1 = Sb1 * w1 + kr1 * vv.y;
            Sa0 = pa0 - bb0 * ska; Sa1 = pa1 - bb1 * ska;
            Sb0 = pb0 - bb0 * skb; Sb1 = pb1 - bb1 * skb;
            const f32x2 ua = Sa1 * rr1 + Sa0 * rr0, ub = Sb1 * rr1 + Sb0 * rr0;
            pwa[(s & 7) * 128] = ua.x + ua.y; pwa[(s & 7) * 128 + 16] = ub.x + ub.y;
#undef LO2
#undef HI2
            if ((s & 7) == 7) {
                const f32x4 p0 = *(const f32x4*)(prd + pr0), p1 = *(const f32x4*)(prd + pr1), p2 = *(const f32x4*)(prd + pr2), p3 = *(const f32x4*)(prd + pr3);
                const f32x4 q = (p0 + p1) + (p2 + p3); const float ov = (q[0] + q[1]) + (q[2] + q[3]);
                po[SROW(c * CH + (s - 7) + psl) * 512 + h * 64 + prow] = (bf16)f2bf(ov);
            }
        }
#undef SC_LD
        if (c + 1 < NCH) SC_WRITE((c + 1) & 1, c + 1);
        __syncthreads();
    }
#undef SROW
#undef SC_LOAD
#undef SC_WRITE
}

__device__ __forceinline__ void rwkv_out(const Frame& F, const Args& A, int l, const MixPtrs& P, bool latent_only, const int dry) {
    typedef float f32x2 __attribute__((ext_vector_type(2)));
    const int gw = F.bid * NWAVES + F.wave, NGW = F.G * NWAVES, c = F.lane * 8, hh = F.lane >> 3;
    const float* gng = A.in[I_GNG] + l * 512 + c; const float* gnb = A.in[I_GNB] + l * 512 + c;
    const float* ka = A.in[I_KA] + l * 512 + c; const float* rk = A.in[I_RK] + l * 512 + c;
    float g8[8], b8[8], ka8[8], rk8[8];
#pragma unroll
    for (int j = 0; j < 8; ++j) { g8[j] = gng[j]; b8[j] = gnb[j]; ka8[j] = ka[j]; rk8[j] = rk[j]; }
    const int nrows = latent_only ? NBATCH * SEQ : TOK;
#pragma unroll 2
    for (int idx = gw; idx < nrows; idx += NGW) {
        const int row = latent_only ? (idx >> 12) * SA + CTXL + (idx & (SEQ - 1)) : idx;
        const size_t o = (size_t)row * 512 + c;
        float o0[8], o1[8], v[8], gg[8], r[8], k[8], a0[8], a1[8];
        unpack8(ldz8(P.O0 + o), o0); unpack8(ldz8(P.O1 + o), o1); unpack8(ldz8(P.RWV + o), v); unpack8(ldz8(P.RWG + o), gg);
        unpack8(ldz8(P.RWR + o), r); unpack8(ldz8(P.RWK + o), k); unpack8(ldz8(P.RWA0 + o), a0); unpack8(ldz8(P.RWA1 + o), a1);
        float bp = 0.f;
#pragma unroll
        for (int j = 0; j < 8; ++j) bp += r[j] * rk8[j] * k[j] * (2.0f + (a0[j] + a1[j] - 2.0f) * ka8[j]);
        const float bonus = group8_sum(bp);
        float sm = 0.f;
#pragma unroll
        for (int j = 0; j < 8; ++j) { o0[j] += o1[j]; sm += o0[j]; }
        const float mu = group8_sum(sm) * (1.0f / 64.0f);
        float vs = 0.f;
#pragma unroll
        for (int j = 0; j < 8; ++j) { o0[j] -= mu; vs += o0[j] * o0[j]; }
        const float rstd = 1.0f / sqrtf(group8_sum(vs) * (1.0f / 64.0f) + GN_EPS);
        float out[8];
#pragma unroll
        for (int j = 0; j < 8; ++j) out[j] = (o0[j] * rstd * g8[j] + b8[j] + bonus * v[j]) * gg[j];
        if (!dry) *(v4u*)(P.RWR + o) = pack8(out); else asm volatile("" :: "v"(out[0]), "v"(out[7]));
    }
}

__device__ __forceinline__ void attention_unit(const Frame& F, const Args& A, int l, bf16* Z, int u, const int dry) {
    char* lds = (char*)F.lds;
    const bool isctx = u >= 1024;
    const bool win = isctx ? (u >= 1056) : (u >= 512);
    int b, h, qrow, NT = 4, bs = 0, q0 = 0;
    if (!isctx) { const int v = u & 511, qb = v & 15; h = (v >> 4) & 3; b = v >> 6; q0 = qb * 256; qrow = CTXL + q0; NT = SA / 64; }
    else { const int v = (u - 1024) & 31; h = v & 3; b = v >> 2; qrow = 0; }
    const int kvh = h >> 1, zc = win ? ZC_WIN : ZC_DENSE;
    bf16* zb = Z + (size_t)b * SA * NZ;
    bf16* Q = zb + (size_t)qrow * NZ + zc + h * 128;
    const bf16* K = zb + zc + 512 + kvh * 128; const bf16* V = zb + zc + 768 + kvh * 128;
    float m0 = -1e30f, l0 = 0.f;
    if (win) { m0 = A.in[I_SINK][l * 4 + h] / att::SCALE; l0 = 1.0f; }
    const bool band = win && !isctx;
    if (band) { bs = q0 >= 128 ? q0 - 128 : 0; const int be = (q0 + 384) < SEQ ? (q0 + 384) : SEQ; NT = 4 + (be - bs) / 64; }
    att::attn_body(band, Q, K, V, Q, NT, bs, q0, m0, l0, lds, dry);
}

#ifndef REP_MOD
#define REP_MOD 1
#endif
#ifndef REP_WI
#define REP_WI 1
#endif
#ifndef REP_WO
#define REP_WO 1
#endif
#ifndef REP_LN
#define REP_LN 1
#endif
#ifndef REP_WIN
#define REP_WIN 1
#endif
#ifndef REP_PREP
#define REP_PREP 1
#endif
#ifndef REP_ATT
#define REP_ATT 1
#endif
#ifndef REP_SCAN
#define REP_SCAN 1
#endif
#ifndef REP_RWO
#define REP_RWO 1
#endif
#ifndef REP_U
#define REP_U 1
#endif
#ifndef REP_G
#define REP_G 1
#endif
#ifndef REP_WOUT
#define REP_WOUT 1
#endif
#define REPEAT(N) for (int rep_ = 0; rep_ < (N); ++rep_) { const int dry = (rep_ + 1 < (N)) ? 1 : 0; (void)dry; if (rep_) __syncthreads();
#define REPEAT_END }

#define PH_BEGIN { GAS unsigned char* wsg_ = (GAS unsigned char*)args.ws; asm volatile("" : "+s"(wsg_)); unsigned char* ws = (unsigned char*)wsg_;     \
    int tid_ = threadIdx.x; asm volatile("" : "+v"(tid_)); \
    Frame F; F.lds = lds; F.tid = tid_; F.lane = tid_ & 63; F.wave = __builtin_amdgcn_readfirstlane(tid_ >> 6); { int g_ = gridDim.x; asm volatile("" : "+s"(g_)); F.G = g_; } F.bid = blockIdx.x; \
    PG8_LAS unsigned char* ldsl = (PG8_LAS unsigned char*)lds; unsigned char* R = ws + WS_R; unsigned char* WB = ws + WS_WB; float* MOD = (float*)(ws + WS_MOD); _Float16* X = (_Float16*)(ws + WS_X); bf16* H = (bf16*)(ws + WS_H); float* STATS = (float*)(ws + WS_STATS); (void)STATS; \
    const float* modl = MOD + (size_t)l * 9 * NMOD; (void)ldsl; (void)R; (void)WB; (void)X; (void)H; (void)modl; (void)F;
#define GRID_BARRIER() do { GAS unsigned char* wsbg_ = (GAS unsigned char*)args.ws; asm volatile("" : "+s"(wsbg_)); unsigned char* wsb_ = (unsigned char*)wsbg_; XcdBarrier b_; b_.bar = (unsigned*)(wsb_ + WS_CTL); b_.x = xb_xcc_id(); b_.st = (volatile LAS unsigned*)((PG8_LAS unsigned char*)lds + MISC_OFF + 32); xcd_barrier(b_); } while (0)
#define PH_END } GRID_BARRIER();
#define MIXPTRS() MixPtrs P; P.Z = (bf16*)(R + R_Z); P.POOL = (bf16*)(R + R_POOL); P.O0 = (bf16*)(R + R_O0); P.O1 = (bf16*)(R + R_O1); P.RWR = (bf16*)(R + R_RWR); P.RWK = (bf16*)(R + R_RWK); P.RWV = (bf16*)(R + R_RWV); \
    P.RWKK = (bf16*)(R + R_RWKK); P.RWA0 = (bf16*)(R + R_RWA0); P.RWA1 = (bf16*)(R + R_RWA1); P.RWG = (bf16*)(R + R_RWG); P.RWW0 = (float*)(R + R_RWW0); P.RWW1 = (float*)(R + R_RWW1); P.BON = (float*)(ws + WS_BON);

__global__ void __launch_bounds__(NTHR, 2) fwd_kernel(Args args) {
    extern __shared__ __attribute__((aligned(16))) unsigned char lds[];
    {
        PG8_LAS unsigned char* ldsl0 = (PG8_LAS unsigned char*)lds;
        for (int u = threadIdx.x; u < (LDS_BYTES - LDSCTL_OFF) / 4; u += NTHR) ((LAS unsigned*)(ldsl0 + LDSCTL_OFF))[u] = 0u;
    }
    __syncthreads();
    (void)xcd_barrier_post((unsigned*)(args.ws + WS_CTL), (volatile LAS unsigned*)((PG8_LAS unsigned char*)lds + MISC_OFF + 32));

    { const int l = 0;
      PH_BEGIN REPEAT(REP_MOD) mod_partial(F, args, (float*)(R + R_MODP)); rope_table(F, (float*)(ws + WS_ROPE), (float*)(ws + WS_IDLN)); convert_ffn(F, args.in[I_F1WI], args.in[I_F1WO], WB, F.bid, F.G); REPEAT_END PH_END
      PH_BEGIN mod_reduce(F, args, (const float*)(R + R_MODP), MOD); PH_END
      PH_BEGIN modulate_input(F, args, MOD, H, X, STATS); PH_END }

#pragma unroll 1
    for (int l = 0; l < 2; ++l) {
        const bool last = (l == 1);
#pragma unroll 1
        for (int f = 0; f < 2; ++f) {
            const int mode = (last && f == 1) ? 1 : 0, nM = mode ? 128 : NPAN;
            PH_BEGIN
              const unsigned char* wbf = (f == 0) ? WB : ws + WS_WB2;
              pg8::Gemm g{H, (const bf16*)(wbf + WB_WI), TOK, 2 * DFF, DM, DM}; pg8::PanelOrder S; S.init(nM, 2 * DFF / 256, F.G, F.bid, mode);
              REPEAT(REP_WI) pg8::EpiSwiglu E{(bf16*)(R + R_MID), DFF, dry}; pg8::gemm_phase<pg8::EpiSwiglu, pg8::PanelOrder, true, true>(ldsl, g, S, E); REPEAT_END
            PH_END
            PH_BEGIN
              const unsigned char* wbf = (f == 0) ? WB : ws + WS_WB2;
              pg8::Gemm g{(const bf16*)(R + R_MID), (const bf16*)(wbf + WB_WO), TOK, DM, DFF, DFF}; pg8::PanelOrder S; S.init(nM, DM / 256, F.G, F.bid, mode);
              const bool first = (l == 0 && f == 0);
              const int pli = f == 0 ? (l * 3 - 1) : (l * 3 + 1);
              const float* lg_ = first ? (const float*)(ws + WS_IDLN) : args.in[I_LNG] + pli * DM; const float* lb_ = first ? (const float*)(ws + WS_IDLN) + DM : args.in[I_LNB] + pli * DM;
              REPEAT(REP_WO) pg8::EpiResid E{X, modl + (f == 0 ? 2 : 8) * DM, DN_ALPHA, 0.5f, dry, STATS, lg_, lb_};
              pg8::gemm_phase<pg8::EpiResid, pg8::PanelOrder, true, true>(ldsl, g, S, E); REPEAT_END
            PH_END
            PH_BEGIN
              const int li = f == 0 ? 0 : 2; const float* g_ = args.in[I_LNG] + (l * 3 + li) * DM; const float* b_ = args.in[I_LNB] + (l * 3 + li) * DM;
              REPEAT(REP_LN)
              if (f == 0) { ln_pass(F, X, STATS, g_, b_, modl, 3, H, nullptr, false, dry); convert_mix(F, args, l, WB, 0, F.bid, F.G); }
              else if (!last) { ln_pass(F, X, STATS, g_, b_, modl + (size_t)9 * NMOD, 0, H, nullptr, false, dry); convert_ffn(F, args.in[I_F1WI] + (size_t)(l + 1) * DM * 2 * DFF, args.in[I_F1WO] + (size_t)(l + 1) * DFF * DM, WB, F.bid, F.G); }
              else ln_pass(F, X, STATS, g_, b_, nullptr, 0, nullptr, args.out, true, dry);
              REPEAT_END
            PH_END
            if (f == 0) {
                const int mmode = last ? 1 : 0, mM = last ? 128 : NPAN;
                PH_BEGIN
                  pg8::Gemm g{H, (const bf16*)(WB + WB_WIN), TOK, NZ, DM, DM}; pg8::PanelOrder S; S.init(NPAN, NZ / 256, F.G, F.bid, 0); pg8::EpiStore E{(bf16*)(R + R_Z), NZ};
                  REPEAT(REP_WIN) pg8::gemm_phase<pg8::EpiStore, pg8::PanelOrder, true, true>(ldsl, g, S, E); REPEAT_END
                PH_END
                PH_BEGIN
                  MIXPTRS();
#pragma unroll 1
                  REPEAT(REP_PREP) for (int ti = F.bid; ti < NBATCH * (SA / 32); ti += F.G) prep_tile<32>(F, args, l, P, WB, (const float*)(ws + WS_ROPE), ti, dry, 2); REPEAT_END
                  if (F.G < 256) { for (int ti = F.bid; ti < NBATCH * 68; ti += F.G) prep_tile<64>(F, args, l, P, WB, (const float*)(ws + WS_ROPE), ti, 0, 1); }
                  { const int rem = (NBATCH * (SA / 32)) % F.G;
                    __syncthreads(); if (rem == 0) convert_mix(F, args, l, WB, 1, F.bid, F.G); else if (F.bid >= rem) convert_mix(F, args, l, WB, 1, F.bid - rem, F.G - rem); }
                PH_END
                PH_BEGIN
                  MIXPTRS();
                  const int nu = last ? 1024 : 1088;
                  const bool split = (F.G >= 256);
                  const int nsc = split ? 128 : F.G, nat = split ? F.G - 128 : F.G, ia = split ? F.bid - 128 : F.bid;
                  if (!split || F.bid >= 128) {
#pragma unroll 1
                    REPEAT(REP_ATT) for (int u = ia; u < nu; u += nat) attention_unit(F, args, l, (bf16*)(R + R_Z), u, dry); REPEAT_END
                    if (split) { __syncthreads();
#pragma unroll 1
                      for (int ti = ia; ti < NBATCH * 68; ti += nat) prep_tile<64>(F, args, l, P, WB, (const float*)(ws + WS_ROPE), ti, 0, 1);
                      convert_ffn(F, args.in[I_F2WI] + (size_t)l * DM * 2 * DFF, args.in[I_F2WO] + (size_t)l * DFF * DM, ws + WS_WB2, ia, nat); }
                  }
                  if (!split || F.bid < 128) {
#pragma unroll 1
                    REPEAT(REP_SCAN) for (int u = F.bid; u < 128; u += nsc) scan_unit(F, args, l, P, u); REPEAT_END
                  }
                PH_END
                PH_BEGIN
                  MIXPTRS();
                  REPEAT(REP_RWO) rwkv_out(F, args, l, P, last, dry); REPEAT_END
                PH_END
#pragma unroll 1
                for (int i2 = 0; i2 < 8; ++i2) {
                    const int i = i2 >> 1;
                    PH_BEGIN
                      if ((i2 & 1) == 0) {
                        const bf16* Ai = i == 0 ? (const bf16*)(R + R_POOL) : i == 1 ? (const bf16*)(R + R_RWR) : i == 2 ? (const bf16*)(R + R_Z) + ZC_WIN : (const bf16*)(R + R_Z) + ZC_DENSE; const int lda = i < 2 ? 512 : NZ;
                        pg8::Gemm g{Ai, (const bf16*)(WB + WB_WUP) + (size_t)i * DM * 512, TOK, DM, 512, lda}; pg8::PanelOrder S; S.init(mM, DM / 256, F.G, F.bid, mmode); pg8::EpiStoreP E{(bf16*)(R + R_UBUF), DM / 256};
                        REPEAT(REP_U) pg8::gemm_phase<pg8::EpiStoreP, pg8::PanelOrder, true, true>(ldsl, g, S, E); REPEAT_END
                      } else {
                        pg8::Gemm g{H, (const bf16*)(WB + WB_WG) + (size_t)i * DM * DM, TOK, DM, DM, DM}; pg8::PanelOrder S; S.init(mM, DM / 256, F.G, F.bid, mmode);
                        REPEAT(REP_G) pg8::EpiGate E{(bf16*)(R + R_ACC), (bf16*)(R + R_O0), (bf16*)(R + R_RWA1), (const bf16*)(R + R_UBUF), args.in[I_BGATE] + (size_t)l * 4 * DM + i * DM, i == 0 ? 1 : 0, i == 3 ? 1 : 0, dry};
                        pg8::gemm_phase<pg8::EpiGate, pg8::PanelOrder, true, true>(ldsl, g, S, E); REPEAT_END
                      }
                    }
                    asm volatile("s_waitcnt vmcnt(0)" ::: "memory"); __syncthreads();
                }
                GRID_BARRIER();
                PH_BEGIN
                  pg8::Gemm g{(const bf16*)(R + R_ACC), (const bf16*)(WB + WB_WOUT), TOK, DM, DM, DM}; pg8::PanelOrder S; S.init(mM, DM / 256, F.G, F.bid, mmode);
                  REPEAT(REP_WOUT) pg8::EpiResid E{X, modl + 5 * DM, DN_ALPHA, 1.0f, dry, STATS, args.in[I_LNG] + (l * 3) * DM, args.in[I_LNB] + (l * 3) * DM};
                  pg8::gemm_phase<pg8::EpiResid, pg8::PanelOrder, true, true>(ldsl, g, S, E); REPEAT_END
                PH_END
                PH_BEGIN
                  const float* g_ = args.in[I_LNG] + (l * 3 + 1) * DM; const float* b_ = args.in[I_LNB] + (l * 3 + 1) * DM;
                  REPEAT(REP_LN) ln_pass(F, X, STATS, g_, b_, modl, 6, H, nullptr, last, dry);
                  if (F.G < 256) convert_ffn(F, args.in[I_F2WI] + (size_t)l * DM * 2 * DFF, args.in[I_F2WO] + (size_t)l * DFF * DM, ws + WS_WB2, F.bid, F.G); REPEAT_END
                PH_END
            }
        }
    }
}

extern "C" void kernel_launch(void* const* d_in, const int* in_sizes, int n_in, void* d_out, int out_size, void* d_ws, size_t ws_size, hipStream_t stream) {
    static int grid = 0;
    if (grid == 0) {
        if (n_in != 32 || in_sizes[0] != NBATCH * SEQ * DM || out_size != NBATCH * SEQ * DM || ws_size < WS_END) {
            fprintf(stderr, "kernel_launch: shape / workspace mismatch (n_in %d, in0 %d, out %d, ws %zu, need %zu); nothing launched\n", n_in, n_in > 0 ? in_sizes[0] : -1, out_size, ws_size, (size_t)WS_END); grid = -1; return; }
        int dev = 0, cus = 0, per_cu = 0;
        if (hipGetDevice(&dev) != hipSuccess || hipDeviceGetAttribute(&cus, hipDeviceAttributeMultiprocessorCount, dev) != hipSuccess) { grid = -1; return; }
        if (hipFuncSetAttribute((const void*)fwd_kernel, hipFuncAttributeMaxDynamicSharedMemorySize, LDS_BYTES) != hipSuccess) { fprintf(stderr, "kernel_launch: hipFuncSetAttribute failed\n"); grid = -1; return; }
        if (hipOccupancyMaxActiveBlocksPerMultiprocessor(&per_cu, (const void*)fwd_kernel, NTHR, LDS_BYTES) != hipSuccess || per_cu < 1) fprintf(stderr, "kernel_launch: occupancy query reports %d\n", per_cu);
        (void)hipGetLastError();
        grid = cus;
    }
    if (grid < 0) return;
    if (hipMemsetAsync((char*)d_ws + WS_CTL, 0, CTL_ZERO_BYTES, stream) != hipSuccess) return;
    Args a{};
    for (int i = 0; i < 32; ++i) a.in[i] = (const float*)d_in[i];
    a.out = (float*)d_out; a.ws = (unsigned char*)d_ws;
    hipLaunchKernelGGL(fwd_kernel, dim3(grid), dim3(NTHR), LDS_BYTES, stream, a);
}
```
